# Optimizing an MI355X kernel written in HIP

```python
import jax, jax.numpy as jnp
from jax import lax
import numpy as np

D_MODEL = 2048
BATCH = 2
SEQ = 4096
DEPTH = 2

N_MIXERS = 2
N_EVEN = (DEPTH + 1) // 2
N_ODD = DEPTH // 2
PLE_DIM = 256
BLOCK = 128
HEAD_DIM = 128
N_HEADS = D_MODEL // HEAD_DIM
GM_WIDTH = D_MODEL
GM_CHUNK = 128
GM_GROUPS = 16
GM_GROUP_DIM = GM_WIDTH // GM_GROUPS
D_FF = 5632
N_EXPERTS = 8
TOP_K = 2
D_FF_EXPERT = 7168
LN_EPS = 1e-5
ALPHA = (2.0 * DEPTH) ** 0.25
BETA = (8.0 * DEPTH) ** -0.25

kernel_name = "fox_gmlp_moe_deepnorm_hybrid"


def layer_norm(x, g, b):
    xf = x.astype(jnp.float32)
    mu = jnp.mean(xf, axis=-1, keepdims=True)
    var = jnp.mean(jnp.square(xf - mu), axis=-1, keepdims=True)
    y = (xf - mu) * lax.rsqrt(var + LN_EPS) * g.astype(jnp.float32) + b.astype(jnp.float32)
    return y.astype(x.dtype)


def fox_mixer(x, w_in, b_f, w_o):
    B, S, _ = x.shape
    h = x @ w_in
    q, k, v, f = jnp.split(h, [D_MODEL, 2 * D_MODEL, 3 * D_MODEL], axis=-1)
    q = q.reshape(B, S, N_HEADS, HEAD_DIM)
    k = k.reshape(B, S, N_HEADS, HEAD_DIM)
    v = v.reshape(B, S, N_HEADS, HEAD_DIM)
    logf = jax.nn.log_sigmoid((f + b_f).astype(jnp.float32))
    c = jnp.cumsum(logf, axis=1).transpose(0, 2, 1)
    nb = S // BLOCK
    qb = q.reshape(B, nb, BLOCK, N_HEADS, HEAD_DIM).swapaxes(0, 1)
    cb = c.reshape(B, N_HEADS, nb, BLOCK).transpose(2, 0, 1, 3)
    kpos = jnp.arange(S)
    scale = HEAD_DIM ** -0.5

    def one_block(args):
        i, qi, ci = args
        s = jnp.einsum('bqhd,bkhd->bhqk', qi, k).astype(jnp.float32) * scale
        s = s + (ci[..., :, None] - c[:, :, None, :])
        qpos = i * BLOCK + jnp.arange(BLOCK)
        s = jnp.where(kpos[None, :] <= qpos[:, None], s, -jnp.inf)
        pr = jax.nn.softmax(s, axis=-1).astype(v.dtype)
        return jnp.einsum('bhqk,bkhd->bqhd', pr, v)

    o = lax.map(one_block, (jnp.arange(nb), qb, cb))
    o = o.swapaxes(0, 1).reshape(B, S, D_MODEL)
    return o @ w_o


def gmlp_mixer(x, w_in, ln_v_g, ln_v_b, w_s, b_s, w_o):
    B, S, _ = x.shape
    z = jax.nn.gelu(x @ w_in)
    u, v = jnp.split(z, 2, axis=-1)
    v = layer_norm(v, ln_v_g, ln_v_b)
    nc = S // GM_CHUNK
    v = v.reshape(B, nc, GM_CHUNK, GM_GROUPS, GM_GROUP_DIM)
    causal = jnp.tril(jnp.ones((GM_CHUNK, GM_CHUNK), dtype=bool))
    w = jnp.where(causal[None], w_s, 0.0)
    mixed = jnp.einsum('gts,bcsgd->bctgd', w, v) + b_s.T[:, :, None]
    y = u * mixed.reshape(B, S, GM_WIDTH)
    return y @ w_o


def swiglu(x, w_gu, w_down):
    g, u = jnp.split(x @ w_gu, 2, axis=-1)
    return (jax.nn.silu(g) * u) @ w_down


def moe_swiglu(x, w_router, w_gu, w_down):
    B, S, Dm = x.shape
    t = x.reshape(B * S, Dm)
    logits = (t @ w_router).astype(jnp.float32)
    top_val, top_idx = lax.top_k(logits, TOP_K)
    gates = jax.nn.softmax(top_val, axis=-1)
    combine = jnp.sum(jax.nn.one_hot(top_idx, N_EXPERTS, dtype=jnp.float32)
                      * gates[..., None], axis=1)
    y = jnp.zeros_like(t)
    for e in range(N_EXPERTS):
        y = y + combine[:, e:e + 1].astype(t.dtype) * swiglu(t, w_gu[e], w_down[e])
    return y.reshape(B, S, Dm)


def setup_inputs(seed: int = 0) -> dict:
    key = jax.random.key(seed)
    ks = jax.random.split(key, 24)
    D, H, W = D_MODEL, N_HEADS, GM_WIDTH
    nrm = jax.random.normal
    x = nrm(ks[0], (BATCH, SEQ, D), jnp.float32)
    p = nrm(ks[1], (DEPTH, BATCH, SEQ, PLE_DIM), jnp.float32)
    col_scale = jnp.concatenate([jnp.ones((2 * D,)), jnp.full((D,), BETA), jnp.ones((H,))])
    fox_w_in = nrm(ks[2], (N_EVEN, D, 3 * D + H)) * D ** -0.5 * col_scale
    fox_b_f = jax.random.uniform(ks[3], (N_EVEN, H), minval=1.0, maxval=4.0)
    fox_w_o = nrm(ks[4], (N_EVEN, D, D)) * D ** -0.5 * BETA
    gm_w_in = nrm(ks[5], (N_ODD, D, 2 * W)) * D ** -0.5
    gm_ln_v_g = 1.0 + 0.05 * nrm(ks[6], (N_ODD, W))
    gm_ln_v_b = 0.01 * nrm(ks[7], (N_ODD, W))
    gm_w_s = nrm(ks[8], (N_ODD, GM_GROUPS, GM_CHUNK, GM_CHUNK)) * GM_CHUNK ** -0.5
    gm_b_s = 1.0 + 0.1 * nrm(ks[9], (N_ODD, GM_GROUPS, GM_CHUNK))
    gm_w_o = nrm(ks[10], (N_ODD, W, D)) * W ** -0.5 * BETA
    ffn_w_gu = nrm(ks[11], (N_EVEN, D, 2 * D_FF)) * D ** -0.5
    ffn_w_down = nrm(ks[12], (N_EVEN, D_FF, D)) * D_FF ** -0.5 * BETA
    moe_w_router = nrm(ks[13], (N_ODD, D, N_EXPERTS)) * D ** -0.5
    moe_w_gu = nrm(ks[14], (N_ODD, N_EXPERTS, D, 2 * D_FF_EXPERT)) * D ** -0.5
    moe_w_down = nrm(ks[15], (N_ODD, N_EXPERTS, D_FF_EXPERT, D)) * D_FF_EXPERT ** -0.5 * BETA
    ln_mix_g = 1.0 + 0.05 * nrm(ks[16], (DEPTH, D))
    ln_mix_b = 0.01 * nrm(ks[17], (DEPTH, D))
    ln_ch_g = 1.0 + 0.05 * nrm(ks[18], (DEPTH, D))
    ln_ch_b = 0.01 * nrm(ks[19], (DEPTH, D))
    ple_w_proj = nrm(ks[20], (DEPTH, PLE_DIM, D)) * PLE_DIM ** -0.5
    ple_w_gate = nrm(ks[21], (DEPTH, D, D)) * D ** -0.5
    return {"x": x, "p": p,
            "fox_w_in": fox_w_in, "fox_b_f": fox_b_f, "fox_w_o": fox_w_o,
            "gm_w_in": gm_w_in, "gm_ln_v_g": gm_ln_v_g, "gm_ln_v_b": gm_ln_v_b,
            "gm_w_s": gm_w_s, "gm_b_s": gm_b_s, "gm_w_o": gm_w_o,
            "ffn_w_gu": ffn_w_gu, "ffn_w_down": ffn_w_down,
            "moe_w_router": moe_w_router, "moe_w_gu": moe_w_gu, "moe_w_down": moe_w_down,
            "ln_mix_g": ln_mix_g, "ln_mix_b": ln_mix_b, "ln_ch_g": ln_ch_g, "ln_ch_b": ln_ch_b,
            "ple_w_proj": ple_w_proj, "ple_w_gate": ple_w_gate}


def reference(x, p, fox_w_in, fox_b_f, fox_w_o, gm_w_in, gm_ln_v_g, gm_ln_v_b,
              gm_w_s, gm_b_s, gm_w_o, ffn_w_gu, ffn_w_down, moe_w_router, moe_w_gu,
              moe_w_down, ln_mix_g, ln_mix_b, ln_ch_g, ln_ch_b, ple_w_proj, ple_w_gate):
    for i in range(DEPTH):
        j = i // N_MIXERS
        if i % N_MIXERS == 0:
            mix = fox_mixer(x, fox_w_in[j], fox_b_f[j], fox_w_o[j])
        else:
            mix = gmlp_mixer(x, gm_w_in[j], gm_ln_v_g[j], gm_ln_v_b[j],
                             gm_w_s[j], gm_b_s[j], gm_w_o[j])
        x = layer_norm(ALPHA * x + mix, ln_mix_g[i], ln_mix_b[i])
        if i % 2 == 0:
            ch = swiglu(x, ffn_w_gu[i // 2], ffn_w_down[i // 2])
        else:
            ch = moe_swiglu(x, moe_w_router[i // 2], moe_w_gu[i // 2], moe_w_down[i // 2])
        x = layer_norm(ALPHA * x + ch, ln_ch_g[i], ln_ch_b[i])
        x = x + jax.nn.sigmoid(x @ ple_w_gate[i]) * (p[i] @ ple_w_proj[i])
    return x
```

```cpp
#include <hip/hip_runtime.h>
#include <hip/hip_bf16.h>
#include <cstdio>
#include <cstdint>
namespace pg8 {
#define PG8_LAS __attribute__((address_space(3)))
typedef unsigned short bf16_t;
typedef short bf16x8 __attribute__((ext_vector_type(8)));
typedef float f32x4 __attribute__((ext_vector_type(4)));
typedef unsigned u32x4 __attribute__((ext_vector_type(4)));
constexpr int BM = 256, BK = 64, HALF = 128, HTB = HALF * BK * 2  , STAGE_BYTES = 8 * HTB, NXCD = 8, WGM = 8;

__host__ __device__ __forceinline__ int lds_byte(int r, int c) { const int st = (r >> 4) * 2 + (c >> 5), rr = r & 15, cc = c & 31, ob = rr * 64 + cc * 2; return st * 1024 + (ob ^ (((ob >> 9) & 1) << 5)); }
__host__ __device__ __forceinline__ void stage_rc(int b, int& R, int& C) { const int st = b / 1024, sb = b % 1024, swz = sb ^ (((sb >> 9) & 1) << 5); R = (st >> 1) * 16 + swz / 64; C = (st & 1) * 32 + (swz % 64) / 2; }
__host__ __device__ __forceinline__ int perm32(int rho) { const int n = rho >> 4, i = rho & 15; return 8 * (i >> 2) + 4 * n + (i & 3); }

struct Unit { int pm, pn, pb; };
struct Gemm { const bf16_t* A; const bf16_t* Bt; int M, N, K; };

struct StaticOrder {
    int nM, nN, nwg, G, c;
    __host__ __device__ void init(int M, int N, int G_, int c_) { nM = M / BM; nN = N / BM; nwg = nM * nN; G = G_; c = c_; }
    __host__ __device__ bool next(int i, Unit& u) const {
        const long L = (long)i * G + c; if (L >= nwg) return false;
        int wgid = (int)L; { const int q = nwg / NXCD, r = nwg % NXCD, xcd = wgid % NXCD, off = wgid / NXCD; wgid = (xcd < r ? xcd * (q + 1) : r * (q + 1) + (xcd - r) * q) + off; }
        const int nig = WGM * nN, gid = wgid / nig, fm = gid * WGM, gsz = (nM - fm) < WGM ? (nM - fm) : WGM;
        u.pm = fm + ((wgid % nig) % gsz); u.pn = (wgid % nig) / gsz; u.pb = u.pn; return true;
    }
    __device__ __forceinline__ void a_ready(const Unit&) const {}
    __device__ __forceinline__ void done(const Unit&) const {}
};

__device__ __forceinline__ unsigned cvt_pk_bf16(float lo, float hi) { unsigned r; asm volatile("v_cvt_pk_bf16_f32 %0, %1, %2" : "=v"(r) : "v"(lo), "v"(hi)); return r; }
typedef float f32x2 __attribute__((ext_vector_type(2)));
typedef float f32x2 __attribute__((ext_vector_type(2)));
typedef unsigned u32x2 __attribute__((ext_vector_type(2)));
__device__ __forceinline__ float fast_sigmoid(float a) { return __builtin_amdgcn_rcpf(1.0f + __builtin_amdgcn_exp2f(-1.4426950408889634f * a)); }
__device__ __forceinline__ float gelu_tanh(float x) { const float u = x * (1.0f + 0.044715f * x * x); return x * __builtin_amdgcn_rcpf(1.0f + __builtin_amdgcn_exp2f(-2.3022081985f * u)); }
__device__ __forceinline__ float bf_lo(unsigned w) { return __uint_as_float(w << 16); }
__device__ __forceinline__ float bf_hi(unsigned w) { return __uint_as_float(w & 0xffff0000u); }

struct EpiBf16S {
    static constexpr bool PERM = true, AFTER_DRAIN = false;
    bf16_t* O; int ldc; int split_cols; size_t split_stride;
    __device__ __forceinline__ void operator()(const f32x4 (&acc)[2][2][4][2], const Unit& u, int wr, int wc, int fr, int fq) const {
        const int row0 = u.pm * BM + wr * 64 + fr; int colt = u.pn * BM; bf16_t* base = O;
        if (split_cols) { const int t = colt / split_cols; base += (size_t)t * split_stride; colt -= t * split_cols; }
        const int col0 = colt + wc * 32 + 8 * fq;
#pragma unroll
        for (int ai = 0; ai < 2; ++ai)
#pragma unroll
            for (int m = 0; m < 4; ++m) { bf16_t* rowp = base + (size_t)(row0 + ai * HALF + m * 16) * ldc + col0;
#pragma unroll
                for (int bj = 0; bj < 2; ++bj) { const f32x4 v0 = acc[ai][bj][m][0], v1 = acc[ai][bj][m][1];
                    u32x4 w; w.x = cvt_pk_bf16(v0[0], v0[1]); w.y = cvt_pk_bf16(v0[2], v0[3]); w.z = cvt_pk_bf16(v1[0], v1[1]); w.w = cvt_pk_bf16(v1[2], v1[3]);
                    *(u32x4*)(rowp + bj * HALF) = w; } }
    }
};
struct EpiGeluStats {
    static constexpr bool PERM = true, AFTER_DRAIN = false;
    bf16_t* O; int ldc; float* stat; int vt0;
    __device__ __forceinline__ void operator()(const f32x4 (&acc)[2][2][4][2], const Unit& u, int wr, int wc, int fr, int fq) const {
        const int row0 = u.pm * BM + wr * 64 + fr; const int col0 = u.pn * BM + wc * 32 + 8 * fq;
        const bool isv = u.pn >= vt0;
#pragma unroll
        for (int ai = 0; ai < 2; ++ai)
#pragma unroll
            for (int m = 0; m < 4; ++m) { const int row = row0 + ai * HALF + m * 16; bf16_t* rowp = O + (size_t)row * ldc + col0; float s = 0.f, q = 0.f;
#pragma unroll
                for (int bj = 0; bj < 2; ++bj) { f32x4 v0 = acc[ai][bj][m][0], v1 = acc[ai][bj][m][1];
#pragma unroll
                    for (int e = 0; e < 4; ++e) { v0[e] = gelu_tanh(v0[e]); v1[e] = gelu_tanh(v1[e]); s += v0[e] + v1[e]; q += v0[e] * v0[e] + v1[e] * v1[e]; }
                    u32x4 w; w.x = cvt_pk_bf16(v0[0], v0[1]); w.y = cvt_pk_bf16(v0[2], v0[3]); w.z = cvt_pk_bf16(v1[0], v1[1]); w.w = cvt_pk_bf16(v1[2], v1[3]);
                    *(u32x4*)(rowp + bj * HALF) = w; }
                if (isv) { s += __shfl_xor(s, 16); s += __shfl_xor(s, 32); q += __shfl_xor(q, 16); q += __shfl_xor(q, 32);
                    if (fq == 0) *(f32x2*)(stat + ((size_t)row * 32 + (u.pn - vt0) * 4 + wc) * 2) = (f32x2){s, q}; } }
    }
};
struct EpiSwiGLU {
    static constexpr bool PERM = true, AFTER_DRAIN = false;
    bf16_t* O; int ldc;
    __device__ __forceinline__ void operator()(const f32x4 (&acc)[2][2][4][2], const Unit& u, int wr, int wc, int fr, int fq) const {
        const int row0 = u.pm * BM + wr * 64 + fr; const int col0 = u.pn * HALF + wc * 32 + 8 * fq;
#pragma unroll
        for (int ai = 0; ai < 2; ++ai)
#pragma unroll
            for (int m = 0; m < 4; ++m) { bf16_t* rowp = O + (size_t)(row0 + ai * HALF + m * 16) * ldc + col0;
                f32x4 h0, h1;
#pragma unroll
                for (int e = 0; e < 4; ++e) { const float g0 = acc[ai][0][m][0][e], g1 = acc[ai][0][m][1][e];
                    h0[e] = g0 * fast_sigmoid(g0) * acc[ai][1][m][0][e]; h1[e] = g1 * fast_sigmoid(g1) * acc[ai][1][m][1][e]; }
                u32x4 w; w.x = cvt_pk_bf16(h0[0], h0[1]); w.y = cvt_pk_bf16(h0[2], h0[3]); w.z = cvt_pk_bf16(h1[0], h1[1]); w.w = cvt_pk_bf16(h1[2], h1[3]);
                *(u32x4*)rowp = w; }
    }
};
struct EpiResF32 {
    static constexpr bool PERM = false, AFTER_DRAIN = false;
    const float* base; float* out; int ldc; float alpha;
    __device__ __forceinline__ void operator()(const f32x4 (&acc)[2][2][4][2], const Unit& u, int wr, int wc, int fr, int fq) const {
        const int row0 = u.pm * BM + wr * 64 + fr; const int col0 = u.pn * BM + wc * 32 + 4 * fq;
#pragma unroll
        for (int ai = 0; ai < 2; ++ai)
#pragma unroll
            for (int m = 0; m < 4; ++m) { const size_t off = (size_t)(row0 + ai * HALF + m * 16) * ldc + col0;
#pragma unroll
                for (int bj = 0; bj < 2; ++bj)
#pragma unroll
                    for (int n = 0; n < 2; ++n) { const f32x4 b = *(const f32x4*)(base + off + bj * HALF + n * 16); *(f32x4*)(out + off + bj * HALF + n * 16) = b * alpha + acc[ai][bj][m][n]; } }
    }
};
struct EpiPLE {
    static constexpr bool PERM = false, AFTER_DRAIN = false;
    const float* x; const bf16_t* pw; float* outF; bf16_t* outB; int ldc;
    __device__ __forceinline__ void operator()(const f32x4 (&acc)[2][2][4][2], const Unit& u, int wr, int wc, int fr, int fq) const {
        const int row0 = u.pm * BM + wr * 64 + fr; const int col0 = u.pn * BM + wc * 32 + 4 * fq;
#pragma unroll
        for (int ai = 0; ai < 2; ++ai)
#pragma unroll
            for (int m = 0; m < 4; ++m) { const size_t off = (size_t)(row0 + ai * HALF + m * 16) * ldc + col0;
#pragma unroll
                for (int bj = 0; bj < 2; ++bj)
#pragma unroll
                    for (int n = 0; n < 2; ++n) { const size_t o2 = off + bj * HALF + n * 16; const f32x4 xv = *(const f32x4*)(x + o2); const u32x2 pv = *(const u32x2*)(pw + o2);
                        const f32x4 a = acc[ai][bj][m][n]; f32x4 o;
                        o[0] = xv[0] + fast_sigmoid(a[0]) * bf_lo(pv.x); o[1] = xv[1] + fast_sigmoid(a[1]) * bf_hi(pv.x);
                        o[2] = xv[2] + fast_sigmoid(a[2]) * bf_lo(pv.y); o[3] = xv[3] + fast_sigmoid(a[3]) * bf_hi(pv.y);
                        *(f32x4*)(outF + o2) = o;
                        if (outB) { u32x2 w; w.x = cvt_pk_bf16(o[0], o[1]); w.y = cvt_pk_bf16(o[2], o[3]); *(u32x2*)(outB + o2) = w; } } }
    }
};
struct MoeOrder {
    int t[9]; int nN, nwg, G, c;
    __device__ __forceinline__ void init(const int (&ts_)[9], int nN_, int G_, int c_) {
#pragma unroll
        for (int j = 0; j < 9; ++j) t[j] = ts_[j];
        nN = nN_; G = G_; c = c_; nwg = t[8] * nN_; }
    __device__ __forceinline__ bool next(int i, Unit& u) const {
        const long L = (long)i * G + c; if (L >= nwg) return false;
        int wgid = (int)L; { const int q = nwg / NXCD, r = nwg % NXCD, xcd = wgid % NXCD, off = wgid / NXCD; wgid = (xcd < r ? xcd * (q + 1) : r * (q + 1) + (xcd - r) * q) + off; }
        int t0 = t[0], t1 = t[1], e = 0;
#pragma unroll
        for (int j = 1; j < 8; ++j) if (wgid >= t[j] * nN) { t0 = t[j]; t1 = t[j + 1]; e = j; }
        const int nt = t1 - t0, loc = wgid - t0 * nN;
        u.pm = t0 + loc % nt; u.pn = loc / nt; u.pb = e * nN + u.pn; return true;
    }
    __device__ __forceinline__ void a_ready(const Unit&) const {}
    __device__ __forceinline__ void done(const Unit&) const {}
};
template <class Epi, class Sched, bool ALIGN_EPI = false, bool SP2 = false>
__device__ __forceinline__ void gemm_phase(PG8_LAS unsigned char* lds, const Gemm g, const Sched& S, const Epi& E) {
    const int tid = threadIdx.x, wid = __builtin_amdgcn_readfirstlane(tid >> 6), lane = tid & 63, wr = wid >> 2, wc = wid & 3, fr = lane & 15, fq = lane >> 4;
    const int K = g.K, nt = K / BK;
    unsigned voffA[2], voffB[2];
#pragma unroll
    for (int i = 0; i < 2; ++i) { int R, C; stage_rc(tid * 16 + i * 8192, R, C); const int Rb = Epi::PERM ? ((R & ~31) + perm32(R & 31)) : R;
        voffA[i] = (unsigned)(R * K + C) * 2u; voffB[i] = (unsigned)(Rb * K + C) * 2u; }
    const size_t kstep = (size_t)(BK * 2);
    const size_t hstep = (size_t)HALF * K * 2;
    const size_t tstep = 2 * hstep;
    const unsigned ldsw = (unsigned)wid * 1024u;
    const int aoff = lds_byte(wr * 64 + fr, fq * 8), boff = lds_byte(wc * 32 + fr, fq * 8);
#define PG8_SA(b, h) (((b) * 2 + (h)) * HTB)
#define PG8_SB(b, h) ((4 + (b) * 2 + (h)) * HTB)
#define PG8_STAGE(bufoff, gbase, voff) do { _Pragma("unroll") for (int _i = 0; _i < 2; ++_i) \
        __builtin_amdgcn_global_load_lds((const unsigned*)((const char*)(gbase) + (voff)[_i]), (PG8_LAS unsigned*)(lds + (bufoff) + ldsw + _i * 8192), 16, 0, 0); } while (0)
#define PG8_LDA(dst, b, h) do { _Pragma("unroll") for (int m = 0; m < 4; ++m) _Pragma("unroll") for (int k = 0; k < 2; ++k) dst[m][k] = *(const PG8_LAS bf16x8*)(lds + PG8_SA(b, h) + aoff + m * 2048 + k * 1024); } while (0)
#define PG8_LDB(dst, b, h) do { _Pragma("unroll") for (int n = 0; n < 2; ++n) _Pragma("unroll") for (int k = 0; k < 2; ++k) dst[n][k] = *(const PG8_LAS bf16x8*)(lds + PG8_SB(b, h) + boff + n * 2048 + k * 1024); } while (0)
#define PG8_MMA(ai, bj, At, Bt) do { __builtin_amdgcn_s_setprio(1); _Pragma("unroll") for (int m = 0; m < 4; ++m) _Pragma("unroll") for (int n = 0; n < 2; ++n) _Pragma("unroll") for (int k = 0; k < 2; ++k) \
        acc[ai][bj][m][n] = __builtin_amdgcn_mfma_f32_16x16x32_bf16(Bt[n][k], At[m][k], acc[ai][bj][m][n], 0, 0, 0); __builtin_amdgcn_s_setprio(0); } while (0)
#define PG8_WAIT_V(n) asm volatile("s_waitcnt vmcnt(" #n ")" ::: "memory")
#define PG8_WAIT_L(n) asm volatile("s_waitcnt lgkmcnt(" #n ")" ::: "memory")
#define PG8_BAR __builtin_amdgcn_s_barrier()
#define PG8_SCHED __builtin_amdgcn_sched_barrier(0)
    Unit cur, nxt; int ui = 0;
    if (!S.next(0, cur)) return;
    f32x4 acc[2][2][4][2];
#pragma unroll
    for (int a = 0; a < 2; ++a)
#pragma unroll
        for (int b = 0; b < 2; ++b)
#pragma unroll
            for (int m = 0; m < 4; ++m)
#pragma unroll
                for (int n = 0; n < 2; ++n) acc[a][b][m][n] = (f32x4){0.f, 0.f, 0.f, 0.f};
    bf16x8 At[4][2], B0[2][2], B1[2][2];
    const char* cA = (const char*)g.A + (size_t)cur.pm * tstep; const char* cB = (const char*)g.Bt + (size_t)cur.pb * tstep;
    S.a_ready(cur);
    if constexpr (SP2) {
        PG8_STAGE(PG8_SB(0, 0), cB, voffB); PG8_STAGE(PG8_SB(0, 1), cB + hstep, voffB); PG8_STAGE(PG8_SA(0, 0), cA, voffA); PG8_STAGE(PG8_SA(0, 1), cA + hstep, voffA);
        if (wr == 1) PG8_BAR;
        PG8_WAIT_V(2); PG8_BAR;
        PG8_STAGE(PG8_SB(1, 0), cB + kstep, voffB); PG8_STAGE(PG8_SA(1, 0), cA + kstep, voffA); PG8_STAGE(PG8_SB(1, 1), cB + hstep + kstep, voffB);
        PG8_WAIT_V(6); PG8_BAR;
    } else {
        PG8_STAGE(PG8_SB(0, 0), cB, voffB); PG8_STAGE(PG8_SA(0, 0), cA, voffA); PG8_STAGE(PG8_SB(0, 1), cB + hstep, voffB); PG8_STAGE(PG8_SA(0, 1), cA + hstep, voffA);
        if (wr == 1) PG8_BAR;
        PG8_WAIT_V(4); PG8_BAR;
        PG8_STAGE(PG8_SB(1, 0), cB + kstep, voffB); PG8_STAGE(PG8_SA(1, 0), cA + kstep, voffA); PG8_STAGE(PG8_SB(1, 1), cB + hstep + kstep, voffB);
        PG8_WAIT_V(6); PG8_BAR;
    }
    for (;;) {
        const bool has_next = S.next(ui + 1, nxt);
        const char* nA = has_next ? (const char*)g.A + (size_t)nxt.pm * tstep : cA; const char* nB = has_next ? (const char*)g.Bt + (size_t)nxt.pb * tstep : cB;
        for (int t = 0; t < nt; t += 2) {
            const bool last = (t == nt - 2);
            const char* a1 = cA + (size_t)(t + 1) * kstep;
            const char* a2 = last ? nA : cA + (size_t)(t + 2) * kstep; const char* b2 = last ? nB : cB + (size_t)(t + 2) * kstep;
            const char* a3 = a2 + kstep; const char* b3 = b2 + kstep;
            if (last && has_next) S.a_ready(nxt);
            if constexpr (SP2) {
            PG8_LDB(B0, 0, 0); PG8_LDB(B1, 0, 1); PG8_SCHED; PG8_LDA(At, 0, 0); PG8_STAGE(PG8_SA(1, 1), a1 + hstep, voffA);
            PG8_WAIT_V(8); PG8_WAIT_L(0); PG8_BAR; PG8_MMA(0, 0, At, B0); PG8_MMA(0, 1, At, B1); PG8_BAR; PG8_SCHED;
            PG8_LDA(At, 0, 1); PG8_STAGE(PG8_SB(0, 0), b2, voffB); PG8_STAGE(PG8_SB(0, 1), b2 + hstep, voffB); PG8_STAGE(PG8_SA(0, 0), a2, voffA);
            PG8_WAIT_V(8); PG8_WAIT_L(0); PG8_BAR; PG8_MMA(1, 0, At, B0); PG8_MMA(1, 1, At, B1); PG8_BAR; PG8_SCHED;
            PG8_LDB(B0, 1, 0); PG8_LDB(B1, 1, 1); PG8_SCHED; PG8_LDA(At, 1, 0); PG8_STAGE(PG8_SA(0, 1), a2 + hstep, voffA);
            PG8_WAIT_V(8); PG8_WAIT_L(0); PG8_BAR; PG8_MMA(0, 0, At, B0); PG8_MMA(0, 1, At, B1); PG8_BAR; PG8_SCHED;
            PG8_LDA(At, 1, 1); PG8_STAGE(PG8_SB(1, 0), b3, voffB); PG8_STAGE(PG8_SB(1, 1), b3 + hstep, voffB); PG8_STAGE(PG8_SA(1, 0), a3, voffA);
            PG8_WAIT_V(8); PG8_WAIT_L(0); PG8_BAR; PG8_MMA(1, 0, At, B0); PG8_MMA(1, 1, At, B1); PG8_BAR; PG8_SCHED;
            } else {
            PG8_LDB(B0, 0, 0); PG8_SCHED; PG8_LDA(At, 0, 0); PG8_STAGE(PG8_SA(1, 1), a1 + hstep, voffA);
            PG8_WAIT_L(8); PG8_BAR; PG8_WAIT_L(0); PG8_MMA(0, 0, At, B0); PG8_BAR; PG8_SCHED;
            PG8_LDB(B1, 0, 1); PG8_STAGE(PG8_SB(0, 0), b2, voffB);
            PG8_BAR; PG8_WAIT_L(0); PG8_MMA(0, 1, At, B1); PG8_BAR;
            PG8_LDA(At, 0, 1); PG8_STAGE(PG8_SA(0, 0), a2, voffA);
            PG8_BAR; PG8_WAIT_L(0); PG8_MMA(1, 0, At, B0); PG8_BAR; PG8_SCHED;
            PG8_STAGE(PG8_SB(0, 1), b2 + hstep, voffB);
            PG8_WAIT_V(6); PG8_BAR; PG8_MMA(1, 1, At, B1); PG8_BAR;
            PG8_LDB(B0, 1, 0); PG8_SCHED; PG8_LDA(At, 1, 0); PG8_STAGE(PG8_SA(0, 1), a2 + hstep, voffA);
            PG8_WAIT_L(8); PG8_BAR; PG8_WAIT_L(0); PG8_MMA(0, 0, At, B0); PG8_BAR; PG8_SCHED;
            PG8_LDB(B1, 1, 1); PG8_STAGE(PG8_SB(1, 0), b3, voffB);
            PG8_BAR; PG8_WAIT_L(0); PG8_MMA(0, 1, At, B1); PG8_BAR;
            PG8_LDA(At, 1, 1); PG8_STAGE(PG8_SA(1, 0), a3, voffA);
            PG8_BAR; PG8_WAIT_L(0); PG8_MMA(1, 0, At, B0); PG8_BAR; PG8_SCHED;
            PG8_STAGE(PG8_SB(1, 1), b3 + hstep, voffB);
            PG8_WAIT_V(6); PG8_BAR; PG8_MMA(1, 1, At, B1); PG8_BAR;
            }
        }
        if constexpr (ALIGN_EPI) { if (wr == 0) PG8_BAR; }
        if constexpr (!Epi::AFTER_DRAIN) { E(acc, cur, wr, wc, fr, fq); S.done(cur); }
        if (!has_next) break;
#pragma unroll
        for (int a = 0; a < 2; ++a)
#pragma unroll
            for (int b = 0; b < 2; ++b)
#pragma unroll
                for (int m = 0; m < 4; ++m)
#pragma unroll
                    for (int n = 0; n < 2; ++n) acc[a][b][m][n] = (f32x4){0.f, 0.f, 0.f, 0.f};
        cur = nxt; cA = nA; cB = nB; ++ui;
        if constexpr (ALIGN_EPI) { if (wr == 1) PG8_BAR; }
    }
    PG8_WAIT_V(0);
    if constexpr (!ALIGN_EPI) { if (wr == 0) PG8_BAR; }
    PG8_BAR;
    if constexpr (Epi::AFTER_DRAIN) { E.fused(acc, cur, wr, wc, fr, fq, lds, wid, lane); S.done(cur); }
#undef PG8_SA
#undef PG8_SB
#undef PG8_STAGE
#undef PG8_LDA
#undef PG8_LDB
#undef PG8_MMA
#undef PG8_WAIT_V
#undef PG8_WAIT_L
#undef PG8_BAR
#undef PG8_SCHED
}
}
namespace fox {
#define FLAS __attribute__((address_space(3)))
using bf16 = __hip_bfloat16;
typedef short bf16x8 __attribute__((ext_vector_type(8)));
typedef short s16x4 __attribute__((ext_vector_type(4)));
typedef float f32x16 __attribute__((ext_vector_type(16)));
typedef float f32x4 __attribute__((ext_vector_type(4)));
typedef unsigned u32x4 __attribute__((ext_vector_type(4)));
constexpr int D = 128, PITCH = 2048, SQ = 4096, NHD = 16;
constexpr float SCALE = 0.08838834764831845f;
constexpr float THR2 = 11.5415603f;
constexpr int NW = 8, QBLK = 32, KVBLK = 64, QB = NW * QBLK;
constexpr int SHM_V = KVBLK * D * 2, SHM_K = KVBLK * D * 2;
constexpr int OFF_WS = 2 * SHM_V + 2 * SHM_K, OFF_KB = OFF_WS + NW * 64 * 4, LDS_BYTES = OFF_KB + SQ * 4;
#define KSWZ(row, colB) ((row) * 256 + ((colB) ^ (((row) & 7) << 4)))
#define SBAR() __builtin_amdgcn_sched_barrier(0)
__device__ __forceinline__ int v_st(int k, int c) { const int kk = (k & ~0xC) | ((k & 4) << 1) | ((k & 8) >> 1); return ((kk >> 3) * 4 + (c >> 5)) * 512 + ((kk & 7) * 32 + (c & 31)) * 2; }
__device__ __forceinline__ int v_rd_base(int lane) { return ((lane & 3) << 3) | (((lane >> 2) & 3) << 6) | (((lane >> 4) & 1) << 5) | (((lane >> 5) & 1) << 8); }
constexpr int v_rd_off(int d0, int ks, int half) { return d0 * 512 + ks * 4096 + half * 2048; }
__device__ __forceinline__ int crow(int r, int hi) { return (r & 3) + 8 * (r >> 2) + 4 * hi; }
__device__ __forceinline__ unsigned cvtpk(float lo, float hi) { unsigned r; asm volatile("v_cvt_pk_bf16_f32 %0, %1, %2" : "=v"(r) : "v"(lo), "v"(hi)); return r; }
__device__ __forceinline__ bf16x8 load8(const bf16* p) { return *reinterpret_cast<const bf16x8*>(p); }
__device__ __forceinline__ void mask_tile(f32x16& p0, f32x16& p1, int dq) {
    const float NEG = -__builtin_inff();
#pragma unroll
    for (int r = 0; r < 16; ++r) { const int c = (r & 3) + 8 * (r >> 2); if (dq - c < 0) p0[r] = NEG; if (dq - c - 32 < 0) p1[r] = NEG; }
}
__device__ __forceinline__ void partialSM(f32x16& p0, f32x16& p1, const FLAS char* kbp, bool domask, int dq, float& m_reg, float& mn, float& alpha) {
    constexpr float C2 = 1.4426950408889634f * SCALE;
#pragma unroll
    for (int j = 0; j < 4; ++j) { const f32x4 b0 = *(const FLAS f32x4*)(kbp + j * 32), b1 = *(const FLAS f32x4*)(kbp + 128 + j * 32);
#pragma unroll
        for (int e = 0; e < 4; ++e) { p0[4 * j + e] = fmaf(p0[4 * j + e], C2, b0[e]); p1[4 * j + e] = fmaf(p1[4 * j + e], C2, b1[e]); } }
    if (domask) mask_tile(p0, p1, dq);
    float pmax = p0[0];
#pragma unroll
    for (int r = 1; r < 16; ++r) pmax = fmaxf(pmax, p0[r]);
#pragma unroll
    for (int r = 0; r < 16; ++r) pmax = fmaxf(pmax, p1[r]);
    { auto rr = __builtin_amdgcn_permlane32_swap(__float_as_uint(pmax), __float_as_uint(pmax), false, false);
      pmax = fmaxf(__uint_as_float(rr[0]), __uint_as_float(rr[1])); }
    if (__builtin_expect(__all(pmax - m_reg <= THR2), 1)) { mn = m_reg; alpha = 1.f; }
    else { mn = fmaxf(m_reg, pmax); alpha = __builtin_amdgcn_exp2f(m_reg - mn); m_reg = mn; }
#pragma unroll
    for (int r = 0; r < 16; ++r) p0[r] = p0[r] - mn;
#pragma unroll
    for (int r = 0; r < 16; ++r) p1[r] = p1[r] - mn;
#pragma unroll
    for (int r = 0; r < 16; ++r) p0[r] = __builtin_amdgcn_exp2f(p0[r]);
}
__device__ __forceinline__ void finishSM(f32x16& p0, f32x16& p1, float alpha, float& l_reg, bf16x8& pa0, bf16x8& pa1, bf16x8& pa2, bf16x8& pa3) {
#pragma unroll
    for (int r = 0; r < 16; ++r) p1[r] = __builtin_amdgcn_exp2f(p1[r]);
    float ps = 0;
#pragma unroll
    for (int r = 0; r < 16; ++r) ps += p0[r];
#pragma unroll
    for (int r = 0; r < 16; ++r) ps += p1[r];
    { auto rr = __builtin_amdgcn_permlane32_swap(__float_as_uint(ps), __float_as_uint(ps), false, false);
      ps = __uint_as_float(rr[0]) + __uint_as_float(rr[1]); }
    l_reg = l_reg * alpha + ps;
#define PK4(P, B_, OUT) do { unsigned a0 = cvtpk(P[B_+0], P[B_+1]), a1 = cvtpk(P[B_+2], P[B_+3]);                          \
        unsigned b0 = cvtpk(P[B_+4], P[B_+5]), b1 = cvtpk(P[B_+6], P[B_+7]);                                             \
        auto r0 = __builtin_amdgcn_permlane32_swap(a0, b0, false, false); auto r1 = __builtin_amdgcn_permlane32_swap(a1, b1, false, false); \
        u32x4 w = {r0[0], r1[0], r0[1], r1[1]}; OUT = *reinterpret_cast<bf16x8*>(&w); } while (0)
    PK4(p0, 0, pa0); PK4(p0, 8, pa1); PK4(p1, 0, pa2); PK4(p1, 8, pa3);
#undef PK4
}
template <int KB>
__device__ __forceinline__ void qkt(f32x16& p0, f32x16& p1, const char* K_lds, int r32, int hi, const bf16x8* qr) {
    p0 = f32x16{}; p1 = f32x16{};
    const char* kb[4];
#pragma unroll
    for (int dd = 0; dd < 4; ++dd) kb[dd] = K_lds + KB * SHM_K + KSWZ(r32, (dd * 16 + hi * 8) * 2);
#pragma unroll
    for (int d0 = 0; d0 < 8; ++d0) { const char* a = kb[d0 & 3] + (d0 >> 2) * 128;
        bf16x8 b0 = *reinterpret_cast<const bf16x8*>(a);
        bf16x8 b1 = *reinterpret_cast<const bf16x8*>(a + 32 * 256);
        p0 = __builtin_amdgcn_mfma_f32_32x32x16_bf16(b0, qr[d0], p0, 0, 0, 0);
        p1 = __builtin_amdgcn_mfma_f32_32x32x16_bf16(b1, qr[d0], p1, 0, 0, 0); }
}
template <int VB>
__device__ __forceinline__ void pv_tile(f32x16* o, int vb0, bf16x8 pa0, bf16x8 pa1, bf16x8 pa2, bf16x8 pa3) {
#define TRRD(dst, off) asm volatile("ds_read_b64_tr_b16 %0, %1 offset:%2" : "=&v"(dst) : "v"(vb0), "i"(off) : "memory")
#define PV_D0(d0) do { s16x4 l0, l1, l2, l3, h0, h1, h2, h3; constexpr int b_ = VB * SHM_V + v_rd_off(d0, 0, 0); \
        TRRD(l0, b_); TRRD(h0, b_ + 2048); TRRD(l1, b_ + 4096); TRRD(h1, b_ + 6144); TRRD(l2, b_ + 8192); TRRD(h2, b_ + 10240); TRRD(l3, b_ + 12288); TRRD(h3, b_ + 14336); \
        asm volatile("s_waitcnt lgkmcnt(0)" ::: "memory"); SBAR();   \
        o[d0] = __builtin_amdgcn_mfma_f32_32x32x16_bf16(pa0, (bf16x8){l0[0], l0[1], l0[2], l0[3], h0[0], h0[1], h0[2], h0[3]}, o[d0], 0, 0, 0);   \
        o[d0] = __builtin_amdgcn_mfma_f32_32x32x16_bf16(pa1, (bf16x8){l1[0], l1[1], l1[2], l1[3], h1[0], h1[1], h1[2], h1[3]}, o[d0], 0, 0, 0);   \
        o[d0] = __builtin_amdgcn_mfma_f32_32x32x16_bf16(pa2, (bf16x8){l2[0], l2[1], l2[2], l2[3], h2[0], h2[1], h2[2], h2[3]}, o[d0], 0, 0, 0);   \
        o[d0] = __builtin_amdgcn_mfma_f32_32x32x16_bf16(pa3, (bf16x8){l3[0], l3[1], l3[2], l3[3], h3[0], h3[1], h3[2], h3[3]}, o[d0], 0, 0, 0); } while (0)
    PV_D0(0); PV_D0(1); PV_D0(2); PV_D0(3);
#undef PV_D0
#undef TRRD
}
struct BlockRef { unsigned qo, kvo; int P0; };
struct Seam { bf16x8 qr[8]; bf16x8 st_v0, st_v1, st_k0, st_k1; };
typedef __amdgpu_buffer_rsrc_t rsrc_t;
constexpr unsigned TB = 8192u * PITCH * 2u;
__device__ __forceinline__ bf16x8 bld8(rsrc_t r, unsigned voff, unsigned soff) { return __builtin_bit_cast(bf16x8, __builtin_amdgcn_raw_buffer_load_b128(r, voff, soff, 0)); }
#define VMW() asm volatile("s_waitcnt vmcnt(0)" ::: "memory")
#define VMWN(n) asm volatile("s_waitcnt vmcnt(%0)" :: "i"(n) : "memory")
#define SLOAD_H(kvo_, k0) do { const unsigned ko_ = TB + (kvo_) + (unsigned)(k0) * (PITCH * 2u), vo_ = ko_ + TB;              \
                         S.st_v0 = bld8(rq, goff0, vo_); S.st_v1 = bld8(rq, goff0, vo_ + 32u * PITCH * 2u); S.st_k0 = bld8(rq, goff0, ko_); S.st_k1 = bld8(rq, goff0, ko_ + 32u * PITCH * 2u); } while (0)
#define SWRITE_HK(bf) do { *(bf16x8*)(K_lds + (bf) * SHM_K + kws) = S.st_k0; *(bf16x8*)(K_lds + (bf) * SHM_K + kws + 32 * 256) = S.st_k1; } while (0)
#define SWRITE_HV(bf) do { *(bf16x8*)(V_lds + (bf) * SHM_V + vst0) = S.st_v0; *(bf16x8*)(V_lds + (bf) * SHM_V + vst1) = S.st_v1; } while (0)
#define SWRITE_H(bf) do { SWRITE_HV(bf); SWRITE_HK(bf); } while (0)
__device__ __forceinline__ void fox_prime(const BlockRef& cur, rsrc_t rq, char* lds, Seam& S) {
    const int tid = threadIdx.x, wid = __builtin_amdgcn_readfirstlane(tid >> 6), lane = tid & 63, r32 = lane & 31, hi = lane >> 5;
    const int sr = tid >> 4, sc = (tid & 15) * 8, kws = KSWZ(sr, sc * 2); char* K_lds = lds + 2 * SHM_V;
    const unsigned goff0 = (unsigned)(sr * PITCH + sc) * 2u, qoff = (unsigned)(r32 * PITCH + hi * 8) * 2u;
    { const unsigned qs_ = cur.qo + (unsigned)(wid * QBLK) * (PITCH * 2u);
#pragma unroll
    for (int d0 = 0; d0 < 8; ++d0) S.qr[d0] = bld8(rq, qoff + d0 * 32, qs_); }
    SLOAD_H(cur.kvo, 0); VMW(); SWRITE_HK(0);
    __syncthreads();
}
__device__ __forceinline__ void fox_block(const BlockRef& cur, const BlockRef& nxt, rsrc_t rq, rsrc_t ro, char* lds, Seam& S) {
    const int tid = threadIdx.x, wid = __builtin_amdgcn_readfirstlane(tid >> 6), lane = tid & 63, r32 = lane & 31, hi = lane >> 5;
    const int NT = (cur.P0 + QB - 1) / KVBLK + 1;
    const int qlo = cur.P0 + wid * QBLK, qm = qlo + r32 - 4 * hi;
    char* V_lds = lds; char* K_lds = lds + 2 * SHM_V;
    float* ws = (float*)(lds + OFF_WS) + wid * 64; float* li_l = ws, * al_l = ws + 32;
    const FLAS char* kb_l = (const FLAS char*)(FLAS char*)(lds + OFF_KB) + hi * 16;
    float m_reg = -1e30f, l_reg = 0; f32x16 o[4] = {};
    const int sr = tid >> 4, sc = (tid & 15) * 8, vst0 = v_st(sr, sc), vst1 = v_st(32 + sr, sc), kws = KSWZ(sr, sc * 2);
    const unsigned goff0 = (unsigned)(sr * PITCH + sc) * 2u, qoff = (unsigned)(r32 * PITCH + hi * 8) * 2u;
    const int vb0 = (int)(uintptr_t)V_lds + v_rd_base(lane);
#define RESC(a) do { if (__any((a) < 1.f)) { if (hi == 0) al_l[r32] = (a); asm volatile("s_waitcnt lgkmcnt(0)" ::: "memory");              \
                     _Pragma("unroll") for (int d_ = 0; d_ < 4; ++d_) _Pragma("unroll") for (int r = 0; r < 16; ++r) o[d_][r] *= al_l[crow(r, hi)]; } } while (0)
#define KBASE(t) ((t) * KVBLK)
#define PSM(P0_, P1_, mnX, alX, t) do { const int kb_ = KBASE(t); partialSM(P0_, P1_, kb_l + kb_ * 4, (kb_ + KVBLK - 1 > qlo), qm - kb_, m_reg, mnX, alX); } while (0)
    constexpr int NQL = 8;
#define SEAM_K0() do { VMWN(NQL); SWRITE_HK(0); SBAR(); } while (0)
    f32x16 pA0, pA1, pB0, pB1; float mnA, mnB, alA, alB; bf16x8 pa0, pa1, pa2, pa3;
    SWRITE_HV(0); SBAR();
    if (NT > 1) { SLOAD_H(cur.kvo, KBASE(1)); }
    SBAR(); qkt<0>(pA0, pA1, K_lds, r32, hi, S.qr);
    PSM(pA0, pA1, mnA, alA, 0);
    if (NT > 1) { VMW(); SWRITE_H(1); }
    __syncthreads();
#define HALF_STEP(PX0, PX1, mnX, alX, PY0, PY1, alY, t, KB, VB, SB) do {                                                      \
        SBAR(); qkt<KB>(PX0, PX1, K_lds, r32, hi, S.qr);                                             \
        finishSM(PY0, PY1, alY, l_reg, pa0, pa1, pa2, pa3); SBAR();                                                           \
        if ((t) + 1 < NT) { SLOAD_H(cur.kvo, KBASE((t) + 1)); SBAR(); }                                               \
        pv_tile<VB>(o, vb0, pa0, pa1, pa2, pa3); PSM(PX0, PX1, mnX, alX, (t));                                        \
        __syncthreads();                                                                                                      \
        if ((t) + 1 < NT) { VMW(); SWRITE_H(SB); }                                                                          \
        RESC(alX); __syncthreads(); } while (0)
    for (int t = 1; t + 1 < NT; t += 2) {
        HALF_STEP(pB0, pB1, mnB, alB, pA0, pA1, alA, t, 1, 0, 0);
        HALF_STEP(pA0, pA1, mnA, alA, pB0, pB1, alB, t + 1, 0, 1, 1);
    }
    const bool even = (NT & 1) == 0;
    if (even) { SBAR(); qkt<1>(pB0, pB1, K_lds, r32, hi, S.qr); SBAR(); }
    SLOAD_H(nxt.kvo, 0); SBAR();
    { const unsigned qs_ = nxt.qo + (unsigned)(wid * QBLK) * (PITCH * 2u);
#pragma unroll
    for (int d0 = 0; d0 < 8; ++d0) S.qr[d0] = bld8(rq, qoff + d0 * 32, qs_); }
    SBAR();
    finishSM(pA0, pA1, alA, l_reg, pa0, pa1, pa2, pa3); SBAR();
    pv_tile<0>(o, vb0, pa0, pa1, pa2, pa3);
    if (even) { PSM(pB0, pB1, mnB, alB, NT - 1); __syncthreads(); RESC(alB);
        finishSM(pB0, pB1, alB, l_reg, pa0, pa1, pa2, pa3); SBAR(); pv_tile<1>(o, vb0, pa0, pa1, pa2, pa3); }
    SBAR(); SEAM_K0();
    if (hi == 0) li_l[r32] = l_reg; asm volatile("s_waitcnt lgkmcnt(0)" ::: "memory");
    float rli[16];
#pragma unroll
    for (int r = 0; r < 16; ++r) rli[r] = __builtin_amdgcn_rcpf(li_l[crow(r, hi)]);
    const unsigned os_ = cur.qo + (unsigned)(wid * QBLK) * (PITCH * 2u), ooff = (unsigned)(4 * hi * PITCH + r32) * 2u;
#pragma unroll
    for (int r = 0; r < 16; ++r) { const unsigned or_ = os_ + (unsigned)((r & 3) + 8 * (r >> 2)) * (PITCH * 2u);
#pragma unroll
        for (int d0 = 0; d0 < 4; ++d0) { const float v = o[d0][r] * rli[r];
            const float vn = __shfl_xor(v, 1);
            if ((r32 & 1) == 0) __builtin_amdgcn_raw_buffer_store_b32(cvtpk(v, vn), ro, ooff + d0 * 64, or_, 0); } }
    __syncthreads();
#undef RESC
#undef KBASE
#undef PSM
#undef SEAM_K0
#undef HALF_STEP
}
#undef VMW
#undef VMWN
#undef SLOAD_H
#undef SWRITE_HK
#undef SWRITE_HV
#undef SWRITE_H
__device__ __forceinline__ BlockRef mkref(int bh, int qb) { BlockRef r; const unsigned row0 = (unsigned)(bh / NHD) * SQ, h = (unsigned)(bh % NHD);
    r.kvo = (row0 * PITCH + h * D) * 2u; r.qo = r.kvo + (unsigned)qb * (QB * PITCH * 2u); r.P0 = qb * QB; return r; }
__device__ __forceinline__ void load_kb(char* lds, const float* kbias, int bh, int tid) {
    const char* src = (const char*)(kbias + (size_t)bh * SQ);
#pragma unroll
    for (int i = 0; i < SQ / 4 / 512; ++i) { const unsigned off = (unsigned)(tid + 512 * i) * 16u; *(f32x4*)(lds + OFF_KB + off) = *(const f32x4*)(src + off); }
}
__device__ __forceinline__ void fox_phase(char* lds, const bf16* QKV, bf16* O, const float* kbias, int vcu, int G) {
    const rsrc_t rq = __builtin_amdgcn_make_buffer_rsrc((void*)QKV, 0, (int)(3u * TB), 0x00020000), ro = __builtin_amdgcn_make_buffer_rsrc((void*)O, 0, (int)TB, 0x00020000);
    constexpr int NQB = SQ / QB, NX = NQB / 2, TOTAL = NX * 32;
    int L = vcu; if (L >= TOTAL) return;
    const int tid = threadIdx.x;
    int bh = L / NX, y = L % NX, pass = 0;
    load_kb(lds, kbias, bh, tid);
    BlockRef cur = mkref(bh, y);
    Seam S;
    fox_prime(cur, rq, lds, S);
    for (;;) {
        const bool more_pass = pass == 0, more_item = L + G < TOTAL, last = !more_pass && !more_item;
        int Ln = L, bhn = bh, yn = y, passn = pass + 1;
        if (!more_pass) { passn = 0; Ln = more_item ? L + G : L; bhn = Ln / NX; yn = Ln % NX; }
        const BlockRef nxt = last ? cur : mkref(bhn, passn ? NQB - 1 - yn : yn);
        fox_block(cur, nxt, rq, ro, lds, S);
        if (last) break;
        if (bhn != bh) { load_kb(lds, kbias, bhn, tid); __syncthreads(); }
        cur = nxt; L = Ln; bh = bhn; y = yn; pass = passn;
    }
}
#undef KSWZ
#undef SBAR
#undef FLAS
}
constexpr int NWAVES = 8;
constexpr int NB = 2, SEQ = 4096, T = NB * SEQ, DM = 2048, NH = 16, HD = 128, FF = 5632, NE = 8, FE = 7168, PD = 256, GCH = 128, GG = 16;
constexpr int NQKV = 3 * DM, WIN_LD = 3 * DM + NH;
constexpr int MOE_ROWS = 18432;
constexpr float LN_EPS = 1e-5f, ALPHA = 1.41421356237309515f;
constexpr float LOG2E = 1.4426950408889634f;
constexpr int N_PHASES = 18;
#ifndef MK_N_LAUNCHES
#define MK_N_LAUNCHES 1
#endif

constexpr size_t MiB = 1u << 20;
constexpr size_t WS_CTL = 0, CTL_ZERO_BYTES = 1 * MiB;
constexpr size_t WS_WQKV = 2 * MiB, WS_WO = 26 * MiB, WS_WGU = 34 * MiB, WS_WDN = 78 * MiB, WS_WPG = 100 * MiB, WS_WPP = 116 * MiB, WS_WGMI = 118 * MiB, WS_WSB = 134 * MiB,
                 WS_WGMO = 135 * MiB, WS_WMGU = 143 * MiB, WS_WMDN = 591 * MiB;
constexpr size_t WS_X0B = 815 * MiB, WS_QKV = 847 * MiB, WS_O = 943 * MiB, WS_PRE = 975 * MiB, WS_X1F = 1039 * MiB, WS_X1B = 1103 * MiB, WS_HB = 1135 * MiB, WS_X2F = 1223 * MiB,
                 WS_X2B = 1287 * MiB, WS_PW = 1319 * MiB, WS_X3F = 1383 * MiB, WS_X3B = 1447 * MiB, WS_UV = 1479 * MiB, WS_VSTAT = 1543 * MiB, WS_YB = 1545 * MiB, WS_X4F = 1577 * MiB,
                 WS_X4B = 1641 * MiB, WS_XS = 1673 * MiB, WS_HM = 1745 * MiB, WS_YS = 1997 * MiB, WS_X5F = 2069 * MiB, WS_X5B = 2133 * MiB, WS_PB = 2165 * MiB, WS_LOGF = 2173 * MiB,
                 WS_KBIAS = 2174 * MiB, WS_ROUTE = 2175 * MiB, WS_END = 2176 * MiB;
static_assert(WS_WMGU + (size_t)NE * 2 * FE * DM * 2 == WS_WMDN && WS_WMDN + (size_t)NE * DM * FE * 2 == WS_X0B, "weight map");
static_assert(WS_HM + (size_t)MOE_ROWS * FE * 2 == WS_YS && WS_HB + (size_t)T * FF * 2 == WS_X2F, "activation map");
constexpr size_t RT_E = 0, RT_POS = 65536, RT_G = 131072, RT_LIST = 196608;
constexpr int CW_TMO = 0, CW_CODE = 1, CW_CNT = 64  , CW_BAR = 4096;

constexpr int RING_BYTES = 131072, LDSCTL_OFF = RING_BYTES, MISC_OFF = LDSCTL_OFF + 320, LDS_BYTES = 147456;

#define GAS __attribute__((address_space(1)))
#define LAS __attribute__((address_space(3)))
typedef unsigned short bf16;
typedef unsigned v4u __attribute__((ext_vector_type(4)));
typedef unsigned v2u __attribute__((ext_vector_type(2)));
typedef float f32x4 __attribute__((ext_vector_type(4)));
typedef float f32x2 __attribute__((ext_vector_type(2)));
typedef short bf16x8 __attribute__((ext_vector_type(8)));
typedef float f32x16 __attribute__((ext_vector_type(16)));
typedef short s16x4 __attribute__((ext_vector_type(4)));
typedef GAS unsigned gu32;
#define RLX_AGENT __ATOMIC_RELAXED, __HIP_MEMORY_SCOPE_AGENT
#define LDS_WAIT() asm volatile("s_waitcnt lgkmcnt(0)" ::: "memory")
#define VM_WAIT() asm volatile("s_waitcnt vmcnt(0)" ::: "memory")
__device__ __forceinline__ unsigned pk2(float lo, float hi) { unsigned r; asm volatile("v_cvt_pk_bf16_f32 %0, %1, %2" : "=v"(r) : "v"(lo), "v"(hi)); return r; }
__device__ __forceinline__ float bflo(unsigned w) { return __uint_as_float(w << 16); }
__device__ __forceinline__ float bfhi(unsigned w) { return __uint_as_float(w & 0xffff0000u); }
__device__ __forceinline__ float wave_sum(float v) {
#pragma unroll
    for (int o = 1; o < 64; o <<= 1) v += __shfl_xor(v, o);
    return v;
}
#define XB_TMO      128
#define XB_XCNT(j)  (256  + 64 * (j))
#define XB_XSUB(j)  (1280 + 64 * (j))
#define XB_XGEN(j)  (2304 + 64 * (j))
#define XB_TOP      3328
#define XB_TOPGEN   3392
#define XCD_BAR_WORDS 3456
#define XB_SPIN_CAP (1u << 18)

__device__ __forceinline__ unsigned xb_ld(unsigned* p)              { return __hip_atomic_load(p, __ATOMIC_RELAXED, __HIP_MEMORY_SCOPE_AGENT); }
__device__ __forceinline__ unsigned xb_add(unsigned* p, unsigned v) { return __hip_atomic_fetch_add(p, v, __ATOMIC_RELAXED, __HIP_MEMORY_SCOPE_AGENT); }
__device__ __forceinline__ unsigned xb_xcc_id() { return (unsigned)__builtin_amdgcn_s_getreg((3 << 11) | 20) & 0xFu; }
#define XB_SPIN(cond, bar) do { unsigned _sp = 0; while (cond) { __builtin_amdgcn_s_sleep(1); \
    if ((++_sp & 255u) == 0u) { if (xb_ld(&(bar)[XB_TMO])) break; if (_sp > XB_SPIN_CAP) { atomicAdd(&(bar)[XB_TMO], 1u); break; } } } } while (0)

struct XcdBarrier {
    unsigned* bar; unsigned x;
    volatile LAS unsigned* st;
};

__device__ __forceinline__ XcdBarrier xcd_barrier_post(unsigned* bar, volatile LAS unsigned* st) {
    XcdBarrier b; b.bar = bar; b.x = xb_xcc_id(); b.st = st;
    if (threadIdx.x == 0) (void)xb_add(&bar[XB_XCNT(b.x)], 1u);
    return b;
}
__device__ __forceinline__ void xcd_barrier_complete(unsigned* bar, unsigned x, unsigned& nloc, unsigned& nx) {
    const unsigned G = gridDim.x * gridDim.y * gridDim.z;
    unsigned sum, cnt, mine, sp = 0u;
    for (;;) {
        sum = 0u; cnt = 0u; mine = 0u;
#pragma unroll
        for (unsigned j = 0; j < 16; ++j) { const unsigned c = xb_ld(&bar[XB_XCNT(j)]); sum += c; cnt += (c > 0u) ? 1u : 0u; mine = (j == x) ? c : mine; }
        if (sum == G) break;
        __builtin_amdgcn_s_sleep(1);
        if ((++sp & 255u) == 0u) { if (xb_ld(&bar[XB_TMO])) break; if (sp > XB_SPIN_CAP) { atomicAdd(&bar[XB_TMO], 1u); break; } }
    }
    nloc = mine > 0u ? mine : 1u; nx = cnt > 0u ? cnt : 1u;
}

__device__ __forceinline__ void xcd_barrier(const XcdBarrier& b) {
    asm volatile("s_waitcnt vmcnt(0)" ::: "memory");
    __syncthreads();
    if (threadIdx.x == 0) {
        unsigned* bar = b.bar;
        __builtin_amdgcn_s_waitcnt(0);
        unsigned nloc = b.st[0], nx = b.st[1];
        if (nloc == 0u) { xcd_barrier_complete(bar, b.x, nloc, nx); b.st[0] = nloc; b.st[1] = nx; }
        const unsigned old = xb_add(&bar[XB_XSUB(b.x)], 1u);
        const unsigned gen = old / nloc;
        if (old + 1u == (gen + 1u) * nloc) {
            __builtin_amdgcn_fence(__ATOMIC_RELEASE, "agent");
            asm volatile("s_waitcnt vmcnt(0)" ::: "memory");
            const unsigned og = xb_add(&bar[XB_TOP], 1u);
            const unsigned tg = og / nx;
            if (og + 1u == (tg + 1u) * nx) xb_add(&bar[XB_TOPGEN], 1u);
            else XB_SPIN(xb_ld(&bar[XB_TOPGEN]) == tg, bar);
            __builtin_amdgcn_fence(__ATOMIC_ACQUIRE, "agent");
            xb_add(&bar[XB_XGEN(b.x)], 1u);
            asm volatile("s_waitcnt vmcnt(0)" ::: "memory");
        } else {
            XB_SPIN(xb_ld(&bar[XB_XGEN(b.x)]) == gen, bar);
            __builtin_amdgcn_fence(__ATOMIC_ACQUIRE, "agent");
            asm volatile("s_waitcnt vmcnt(0)" ::: "memory");
        }
    }
    __syncthreads();
}
__device__ __forceinline__ void transpose_item(const float* W, int ldw, int k0, int n0, bf16* WT, int K, int dr0, LAS float* scr, int lane) {
#pragma unroll 8
    for (int i = 0; i < 32; ++i) { const int kk = 2 * i + (lane >> 5); scr[kk * 33 + (lane & 31)] = W[(size_t)(k0 + kk) * ldw + n0 + (lane & 31)]; }
    LDS_WAIT(); asm volatile("" ::: "memory");
    const int c = lane & 7;
#pragma unroll
    for (int j = 0; j < 4; ++j) { const int n = (lane >> 3) + 8 * j; const LAS float* s = scr + (8 * c) * 33 + n;
        v4u o; o.x = pk2(s[0 * 33], s[1 * 33]); o.y = pk2(s[2 * 33], s[3 * 33]); o.z = pk2(s[4 * 33], s[5 * 33]); o.w = pk2(s[6 * 33], s[7 * 33]);
        *(GAS v4u*)(WT + (size_t)(dr0 + n) * K + k0 + 8 * c) = o; }
    LDS_WAIT(); asm volatile("" ::: "memory");
}
__device__ __forceinline__ int gu_row(int n, int F) { const int isu = n >= F ? 1 : 0, j = n - isu * F; return (j >> 7) * 256 + isu * 128 + (j & 127); }
__device__ __forceinline__ float log_sigmoid(float z) { return fminf(z, 0.f) - log1pf(expf(-fabsf(z))); }

__device__ __forceinline__ const void* karg_ptr(int i) {
    const __attribute__((address_space(4))) char* ka = (const __attribute__((address_space(4))) char*)__builtin_amdgcn_kernarg_segment_ptr();
    return *(const void* const __attribute__((address_space(4)))*)(ka + 8 * i);
}
#define KIN(i) ((const float*)karg_ptr(i))
__device__ __forceinline__ void p0_prologue(unsigned char* ws, LAS unsigned char* lds, int tid, int lane, int wave, int vcu, int G) {
    const int gw = vcu * NWAVES + wave, NGW = G * NWAVES;
    LAS float* wf = (LAS float*)lds;
    for (int i = tid; i < DM * 4; i += NWAVES * 64) { const int k = i >> 2, hq = i & 3; const f32x4 w = *(const f32x4*)(KIN(2) + (size_t)k * WIN_LD + NQKV + hq * 4);
        wf[(hq * 4 + 0) * DM + k] = w[0]; wf[(hq * 4 + 1) * DM + k] = w[1]; wf[(hq * 4 + 2) * DM + k] = w[2]; wf[(hq * 4 + 3) * DM + k] = w[3]; }
    __syncthreads();
    bf16* xb = (bf16*)(ws + WS_X0B); float* logf_o = (float*)(ws + WS_LOGF);
    for (int tb = gw; tb < T / 4; tb += NGW) {
        float acc[4][16];
#pragma unroll
        for (int a = 0; a < 4; ++a)
#pragma unroll
            for (int h = 0; h < 16; ++h) acc[a][h] = 0.f;
#pragma unroll 1
        for (int j = 0; j < 8; ++j) {
            f32x4 xv[4];
#pragma unroll
            for (int a = 0; a < 4; ++a) { xv[a] = *(const f32x4*)(KIN(0) + (size_t)(4 * tb + a) * DM + 256 * j + 4 * lane);
                v2u o; o.x = pk2(xv[a][0], xv[a][1]); o.y = pk2(xv[a][2], xv[a][3]); *(v2u*)(xb + (size_t)(4 * tb + a) * DM + 256 * j + 4 * lane) = o; }
#pragma unroll
            for (int h = 0; h < 16; ++h) { const f32x4 w = *(const LAS f32x4*)(wf + h * DM + 256 * j + 4 * lane);
#pragma unroll
                for (int a = 0; a < 4; ++a) acc[a][h] += (xv[a][0] * w[0] + xv[a][1] * w[1]) + (xv[a][2] * w[2] + xv[a][3] * w[3]); }
        }
        float mine = 0.f;
#pragma unroll
        for (int a = 0; a < 4; ++a)
#pragma unroll
            for (int h = 0; h < 16; ++h) { const float s = wave_sum(acc[a][h]); mine = (lane == a * 16 + h) ? s : mine; }
        logf_o[(size_t)(4 * tb) * 16 + lane] = log_sigmoid(mine + KIN(3)[lane & 15]);
    }
    __syncthreads();
    LAS float* scr = (LAS float*)(lds + wave * 8448);
    constexpr int I_QKV = (DM / 64) * (NQKV / 32), I_SQ = (DM / 64) * (DM / 32), I_GU = (DM / 64) * (2 * FF / 32), I_DN = (FF / 64) * (DM / 32), I_PP = (PD / 64) * (DM / 32),
                  I_GMI = (DM / 64) * (2 * DM / 32), I_MGU = (DM / 64) * (2 * FE / 32), I_MDN = (FE / 64) * (DM / 32);
    constexpr int NITEMS = I_QKV + I_SQ + I_GU + I_DN + 2 * I_SQ + 2 * I_PP + I_GMI + I_SQ + NE * I_MGU + NE * I_MDN;
    for (int it = gw; it < NITEMS; it += NGW) {
        int r = it;
        if (r < I_QKV) { const int nb = NQKV / 32, kb = r / nb, n0 = (r % nb) * 32; transpose_item(KIN(2), WIN_LD, kb * 64, n0, (bf16*)(ws + WS_WQKV), DM, n0, scr, lane); continue; } r -= I_QKV;
        if (r < I_SQ) { const int nb = DM / 32, kb = r / nb, n0 = (r % nb) * 32; transpose_item(KIN(4), DM, kb * 64, n0, (bf16*)(ws + WS_WO), DM, n0, scr, lane); continue; } r -= I_SQ;
        if (r < I_GU) { const int nb = 2 * FF / 32, kb = r / nb, n0 = (r % nb) * 32; transpose_item(KIN(11), 2 * FF, kb * 64, n0, (bf16*)(ws + WS_WGU), DM, gu_row(n0, FF), scr, lane); continue; } r -= I_GU;
        if (r < I_DN) { const int nb = DM / 32, kb = r / nb, n0 = (r % nb) * 32; transpose_item(KIN(12), DM, kb * 64, n0, (bf16*)(ws + WS_WDN), FF, n0, scr, lane); continue; } r -= I_DN;
        if (r < 2 * I_SQ) { const int l = r / I_SQ, q = r % I_SQ, nb = DM / 32, kb = q / nb, n0 = (q % nb) * 32;
            transpose_item(KIN(21) + (size_t)l * DM * DM, DM, kb * 64, n0, (bf16*)(ws + WS_WPG) + (size_t)l * DM * DM, DM, n0, scr, lane); continue; } r -= 2 * I_SQ;
        if (r < 2 * I_PP) { const int l = r / I_PP, q = r % I_PP, nb = DM / 32, kb = q / nb, n0 = (q % nb) * 32;
            transpose_item(KIN(20) + (size_t)l * PD * DM, DM, kb * 64, n0, (bf16*)(ws + WS_WPP) + (size_t)l * DM * PD, PD, n0, scr, lane); continue; } r -= 2 * I_PP;
        if (r < I_GMI) { const int nb = 2 * DM / 32, kb = r / nb, n0 = (r % nb) * 32; transpose_item(KIN(5), 2 * DM, kb * 64, n0, (bf16*)(ws + WS_WGMI), DM, n0, scr, lane); continue; } r -= I_GMI;
        if (r < I_SQ) { const int nb = DM / 32, kb = r / nb, n0 = (r % nb) * 32; transpose_item(KIN(10), DM, kb * 64, n0, (bf16*)(ws + WS_WGMO), DM, n0, scr, lane); continue; } r -= I_SQ;
        if (r < NE * I_MGU) { const int e = r / I_MGU, q = r % I_MGU, nb = 2 * FE / 32, kb = q / nb, n0 = (q % nb) * 32;
            transpose_item(KIN(14) + (size_t)e * DM * 2 * FE, 2 * FE, kb * 64, n0, (bf16*)(ws + WS_WMGU) + (size_t)e * 2 * FE * DM, DM, gu_row(n0, FE), scr, lane); continue; } r -= NE * I_MGU;
        { const int e = r / I_MDN, q = r % I_MDN, nb = DM / 32, kb = q / nb, n0 = (q % nb) * 32;
            transpose_item(KIN(15) + (size_t)e * FE * DM, DM, kb * 64, n0, (bf16*)(ws + WS_WMDN) + (size_t)e * DM * FE, FE, n0, scr, lane); }
    }
    const int gt = vcu * (NWAVES * 64) + tid, NGT = G * NWAVES * 64;
    { bf16* pb = (bf16*)(ws + WS_PB);
      for (int i = gt; i < 2 * T * PD / 8; i += NGT) { const f32x4 a = *(const f32x4*)(KIN(1) + (size_t)i * 8), b = *(const f32x4*)(KIN(1) + (size_t)i * 8 + 4);
          v4u o; o.x = pk2(a[0], a[1]); o.y = pk2(a[2], a[3]); o.z = pk2(b[0], b[1]); o.w = pk2(b[2], b[3]); *(v4u*)(pb + (size_t)i * 8) = o; } }
    { bf16* wsb = (bf16*)(ws + WS_WSB);
      for (int i = gt; i < GG * GCH * GCH / 8; i += NGT) { const int s0 = (i * 8) & (GCH - 1), t = ((i * 8) >> 7) & (GCH - 1);
          const f32x4 a = *(const f32x4*)(KIN(8) + (size_t)i * 8), b = *(const f32x4*)(KIN(8) + (size_t)i * 8 + 4);
          float v[8] = {a[0], a[1], a[2], a[3], b[0], b[1], b[2], b[3]};
#pragma unroll
          for (int e = 0; e < 8; ++e) v[e] = (s0 + e <= t) ? v[e] : 0.f;
          v4u o; o.x = pk2(v[0], v[1]); o.y = pk2(v[2], v[3]); o.z = pk2(v[4], v[5]); o.w = pk2(v[6], v[7]); *(v4u*)(wsb + (size_t)i * 8) = o; } }
}
__device__ __forceinline__ void cumsum_seq(const float* logf_i, float* kbias, int s, LAS unsigned char* lds, int tid, int lane, int wave) {
    const int b = s >> 4, h = s & 15; double v[8]; double run = 0.0;
#pragma unroll
    for (int e = 0; e < 8; ++e) { run += (double)logf_i[((size_t)b * SEQ + tid * 8 + e) * 16 + h]; v[e] = run; }
    double inc = run;
#pragma unroll
    for (int o = 1; o < 64; o <<= 1) { const double u = __shfl_up(inc, o); if (lane >= o) inc += u; }
    LAS double* wt = (LAS double*)lds;
    if (lane == 63) wt[wave] = inc;
    __syncthreads();
    double base = inc - run;
    for (int w = 0; w < wave; ++w) base += wt[w];
#pragma unroll
    for (int e = 0; e < 8; ++e) kbias[(size_t)s * SEQ + tid * 8 + e] = (float)(-(base + v[e]) * 1.4426950408889634);
    __syncthreads();
}
__device__ __forceinline__ void ln_row(f32x4 (&v)[8], const float* g, const float* b, int lane) {
    float s = 0.f;
#pragma unroll
    for (int j = 0; j < 8; ++j) s += (v[j][0] + v[j][1]) + (v[j][2] + v[j][3]);
    const float mean = wave_sum(s) * (1.f / DM); float s2 = 0.f;
#pragma unroll
    for (int j = 0; j < 8; ++j) { v[j] = v[j] - mean; s2 += (v[j][0] * v[j][0] + v[j][1] * v[j][1]) + (v[j][2] * v[j][2] + v[j][3] * v[j][3]); }
    const float rstd = 1.0f / sqrtf(wave_sum(s2) * (1.f / DM) + LN_EPS);
#pragma unroll
    for (int j = 0; j < 8; ++j) { const f32x4 gv = *(const f32x4*)(g + 256 * j + 4 * lane), bv = *(const f32x4*)(b + 256 * j + 4 * lane); v[j] = v[j] * rstd * gv + bv; }
}
__device__ __forceinline__ void store_row(const f32x4 (&v)[8], float* of, bf16* ob, int lane) {
#pragma unroll
    for (int j = 0; j < 8; ++j) { *(f32x4*)(of + 256 * j + 4 * lane) = v[j]; v2u o; o.x = pk2(v[j][0], v[j][1]); o.y = pk2(v[j][2], v[j][3]); *(v2u*)(ob + 256 * j + 4 * lane) = o; }
}
__device__ __forceinline__ void ln_phase(const float* pre, const float* g, const float* b, float* of, bf16* ob, int lane, int gw, int NGW) {
    for (int m = gw; m < T; m += NGW) { f32x4 v[8];
#pragma unroll
        for (int j = 0; j < 8; ++j) v[j] = *(const f32x4*)(pre + (size_t)m * DM + 256 * j + 4 * lane);
        ln_row(v, g, b, lane); store_row(v, of + (size_t)m * DM, ob + (size_t)m * DM, lane); }
}
__device__ __forceinline__ void ln_router_phase(const float* pre, const float* g, const float* b, float* of, bf16* ob, const float* w_router, unsigned char* route, gu32* ctl,
                                                LAS unsigned char* lds, int tid, int lane, int gw, int NGW) {
    LAS float* wr = (LAS float*)lds;
    for (int i = tid; i < DM * 2; i += NWAVES * 64) { const int k = i >> 1, eq = i & 1; const f32x4 w = *(const f32x4*)(w_router + (size_t)k * NE + eq * 4);
        wr[(eq * 4 + 0) * DM + k] = w[0]; wr[(eq * 4 + 1) * DM + k] = w[1]; wr[(eq * 4 + 2) * DM + k] = w[2]; wr[(eq * 4 + 3) * DM + k] = w[3]; }
    __syncthreads();
    int* tok_e = (int*)(route + RT_E); int* tok_pos = (int*)(route + RT_POS); float* tok_g = (float*)(route + RT_G); int* elist = (int*)(route + RT_LIST);
    for (int m = gw; m < T; m += NGW) { f32x4 v[8];
#pragma unroll
        for (int j = 0; j < 8; ++j) v[j] = *(const f32x4*)(pre + (size_t)m * DM + 256 * j + 4 * lane);
        ln_row(v, g, b, lane); store_row(v, of + (size_t)m * DM, ob + (size_t)m * DM, lane);
        float lg[8];
#pragma unroll
        for (int e = 0; e < 8; ++e) { float a = 0.f;
#pragma unroll
            for (int j = 0; j < 8; ++j) { const f32x4 w = *(const LAS f32x4*)(wr + e * DM + 256 * j + 4 * lane); a += (v[j][0] * w[0] + v[j][1] * w[1]) + (v[j][2] * w[2] + v[j][3] * w[3]); }
            lg[e] = wave_sum(a); }
        int i1 = 0; float v1 = lg[0];
#pragma unroll
        for (int e = 1; e < 8; ++e) if (lg[e] > v1) { v1 = lg[e]; i1 = e; }
        int i2 = -1; float v2 = -__builtin_inff();
#pragma unroll
        for (int e = 0; e < 8; ++e) if (e != i1 && lg[e] > v2) { v2 = lg[e]; i2 = e; }
        const float ex = expf(v2 - v1), g1 = 1.0f / (1.0f + ex), g2 = ex / (1.0f + ex);
        if (lane == 0) { const int p1 = (int)__hip_atomic_fetch_add(ctl + CW_CNT + 64 * i1, 1u, RLX_AGENT), p2 = (int)__hip_atomic_fetch_add(ctl + CW_CNT + 64 * i2, 1u, RLX_AGENT);
            tok_e[2 * m] = i1; tok_e[2 * m + 1] = i2; tok_pos[2 * m] = p1; tok_pos[2 * m + 1] = p2; tok_g[2 * m] = g1; tok_g[2 * m + 1] = g2;
            elist[i1 * T + p1] = m; elist[i2 * T + p2] = m; }
    }
    __syncthreads();
}
__device__ __forceinline__ void moe_tiles(const gu32* ctl, int (&ts)[9], int (&cnt)[8]) {
    ts[0] = 0;
#pragma unroll
    for (int e = 0; e < 8; ++e) { cnt[e] = __builtin_amdgcn_readfirstlane((int)__hip_atomic_load(ctl + CW_CNT + 64 * e, RLX_AGENT)); ts[e + 1] = ts[e] + ((cnt[e] + 255) >> 8); }
}
__device__ __forceinline__ void moe_permute_phase(const bf16* x4b, bf16* xs, const unsigned char* route, const gu32* ctl, int lane, int gw, int NGW) {
    int ts[9], cnt[8]; moe_tiles(ctl, ts, cnt);
    const int* elist = (const int*)(route + RT_LIST);
    for (int r = gw; r < ts[8] * 256; r += NGW) { const int mt = r >> 8; int e = 0, t0 = 0, c = cnt[0];
#pragma unroll
        for (int j = 1; j < 8; ++j) if (mt >= ts[j]) { e = j; t0 = ts[j]; c = cnt[j]; }
        const int pos = r - t0 * 256; v4u a[4];
        if (pos < c) { const int tok = elist[e * T + pos];
#pragma unroll
            for (int j = 0; j < 4; ++j) a[j] = *(const v4u*)(x4b + (size_t)tok * DM + 512 * j + 8 * lane); }
        else {
#pragma unroll
            for (int j = 0; j < 4; ++j) a[j] = (v4u){0u, 0u, 0u, 0u}; }
#pragma unroll
        for (int j = 0; j < 4; ++j) *(v4u*)(xs + (size_t)r * DM + 512 * j + 8 * lane) = a[j]; }
}
__device__ __forceinline__ void ln_moe_phase(const float* x4, const bf16* ys, const float* g, const float* b, float* of, bf16* ob, const unsigned char* route, const gu32* ctl, int lane, int gw, int NGW) {
    int ts[9], cnt[8]; moe_tiles(ctl, ts, cnt);
    const int* tok_e = (const int*)(route + RT_E); const int* tok_pos = (const int*)(route + RT_POS); const float* tok_g = (const float*)(route + RT_G);
    for (int m = gw; m < T; m += NGW) {
        const int e1 = __builtin_amdgcn_readfirstlane(tok_e[2 * m]), e2 = __builtin_amdgcn_readfirstlane(tok_e[2 * m + 1]);
        const int p1 = __builtin_amdgcn_readfirstlane(tok_pos[2 * m]), p2 = __builtin_amdgcn_readfirstlane(tok_pos[2 * m + 1]);
        const float g1 = tok_g[2 * m], g2 = tok_g[2 * m + 1];
        int t1 = 0, t2 = 0;
#pragma unroll
        for (int j = 0; j < 8; ++j) { t1 = (e1 == j) ? ts[j] : t1; t2 = (e2 == j) ? ts[j] : t2; }
        const bf16* y1 = ys + (size_t)(t1 * 256 + p1) * DM; const bf16* y2 = ys + (size_t)(t2 * 256 + p2) * DM;
        f32x4 v[8];
#pragma unroll
        for (int j = 0; j < 8; ++j) { const f32x4 xv = *(const f32x4*)(x4 + (size_t)m * DM + 256 * j + 4 * lane); const v2u a = *(const v2u*)(y1 + 256 * j + 4 * lane), c = *(const v2u*)(y2 + 256 * j + 4 * lane);
            f32x4 o; o[0] = ALPHA * xv[0] + (g1 * bflo(a.x) + g2 * bflo(c.x)); o[1] = ALPHA * xv[1] + (g1 * bfhi(a.x) + g2 * bfhi(c.x));
            o[2] = ALPHA * xv[2] + (g1 * bflo(a.y) + g2 * bflo(c.y)); o[3] = ALPHA * xv[3] + (g1 * bfhi(a.y) + g2 * bfhi(c.y)); v[j] = o; }
        ln_row(v, g, b, lane); store_row(v, of + (size_t)m * DM, ob + (size_t)m * DM, lane); }
}
__device__ __forceinline__ void gating_unit(int uid, const bf16* uv, const float* vstat, const bf16* wsb, const float* lng, const float* lnb, const float* bs, bf16* yb,
                                            LAS unsigned char* lds, int tid, int lane, int wave) {
    const int bc = uid >> 4, g = uid & 15, tok0 = bc * GCH;
    LAS float* st = (LAS float*)(lds + 32768);
    if (tid < GCH) { const f32x4* sp = (const f32x4*)(vstat + (size_t)(tok0 + tid) * 64); float s = 0.f, q = 0.f;
#pragma unroll
        for (int i = 0; i < 16; ++i) { const f32x4 a = sp[i]; s += a[0] + a[2]; q += a[1] + a[3]; }
        const float mean = s * (1.f / DM), var = fmaxf(q * (1.f / DM) - mean * mean, 0.f);
        st[2 * tid] = mean; st[2 * tid + 1] = 1.0f / sqrtf(var + LN_EPS); }
    __syncthreads();
    { const int sr = tid >> 4, sc = (tid & 15) * 8;
      const f32x4 g0 = *(const f32x4*)(lng + g * GCH + sc), g1 = *(const f32x4*)(lng + g * GCH + sc + 4), b0 = *(const f32x4*)(lnb + g * GCH + sc), b1 = *(const f32x4*)(lnb + g * GCH + sc + 4);
#pragma unroll
      for (int q = 0; q < 4; ++q) { const int s = 32 * q + sr; const v4u raw = *(const v4u*)(uv + (size_t)(tok0 + s) * (2 * DM) + DM + g * GCH + sc);
          const float mean = st[2 * s], rstd = st[2 * s + 1];
          float f[8] = {bflo(raw.x), bfhi(raw.x), bflo(raw.y), bfhi(raw.y), bflo(raw.z), bfhi(raw.z), bflo(raw.w), bfhi(raw.w)};
#pragma unroll
          for (int e = 0; e < 4; ++e) { f[e] = (f[e] - mean) * rstd * g0[e] + b0[e]; f[4 + e] = (f[4 + e] - mean) * rstd * g1[e] + b1[e]; }
          v4u o; o.x = pk2(f[0], f[1]); o.y = pk2(f[2], f[3]); o.z = pk2(f[4], f[5]); o.w = pk2(f[6], f[7]);
          *(LAS v4u*)(lds + (s >> 6) * fox::SHM_V + fox::v_st(s & 63, sc)) = o; } }
    __syncthreads();
    const int r32 = lane & 31, hi = lane >> 5, ib = wave >> 1, dh = wave & 1;
    bf16x8 pa[8];
#pragma unroll
    for (int ks = 0; ks < 8; ++ks) pa[ks] = *(const bf16x8*)(wsb + ((size_t)(g * GCH + 32 * ib + r32)) * GCH + 16 * ks + 8 * hi);
    const int vb0 = (int)(uintptr_t)lds + fox::v_rd_base(lane) + dh * 1024;
    f32x16 o[2] = {};
#define G_TRRD(dst, off) asm volatile("ds_read_b64_tr_b16 %0, %1 offset:%2" : "=&v"(dst) : "v"(vb0), "i"(off) : "memory")
#define G_D0(ti, dd) do { s16x4 l0, l1, l2, l3, h0, h1, h2, h3; \
        G_TRRD(l0, (ti) * 16384 + (dd) * 512); G_TRRD(h0, (ti) * 16384 + (dd) * 512 + 2048); G_TRRD(l1, (ti) * 16384 + (dd) * 512 + 4096); G_TRRD(h1, (ti) * 16384 + (dd) * 512 + 6144); \
        G_TRRD(l2, (ti) * 16384 + (dd) * 512 + 8192); G_TRRD(h2, (ti) * 16384 + (dd) * 512 + 10240); G_TRRD(l3, (ti) * 16384 + (dd) * 512 + 12288); G_TRRD(h3, (ti) * 16384 + (dd) * 512 + 14336); \
        asm volatile("s_waitcnt lgkmcnt(0)" ::: "memory"); __builtin_amdgcn_sched_barrier(0); \
        o[dd] = __builtin_amdgcn_mfma_f32_32x32x16_bf16(pa[4 * (ti) + 0], (bf16x8){l0[0], l0[1], l0[2], l0[3], h0[0], h0[1], h0[2], h0[3]}, o[dd], 0, 0, 0); \
        o[dd] = __builtin_amdgcn_mfma_f32_32x32x16_bf16(pa[4 * (ti) + 1], (bf16x8){l1[0], l1[1], l1[2], l1[3], h1[0], h1[1], h1[2], h1[3]}, o[dd], 0, 0, 0); \
        o[dd] = __builtin_amdgcn_mfma_f32_32x32x16_bf16(pa[4 * (ti) + 2], (bf16x8){l2[0], l2[1], l2[2], l2[3], h2[0], h2[1], h2[2], h2[3]}, o[dd], 0, 0, 0); \
        o[dd] = __builtin_amdgcn_mfma_f32_32x32x16_bf16(pa[4 * (ti) + 3], (bf16x8){l3[0], l3[1], l3[2], l3[3], h3[0], h3[1], h3[2], h3[3]}, o[dd], 0, 0, 0); } while (0)
    G_D0(0, 0); G_D0(0, 1); G_D0(1, 0); G_D0(1, 1);
#undef G_D0
#undef G_TRRD
#pragma unroll
    for (int r = 0; r < 16; ++r) { const int t = 32 * ib + fox::crow(r, hi); const float bsv = bs[g * GCH + t];
#pragma unroll
        for (int dd = 0; dd < 2; ++dd) { const int col = g * GCH + (2 * dh + dd) * 32 + r32;
            const float uval = __uint_as_float((unsigned)uv[(size_t)(tok0 + t) * (2 * DM) + col] << 16);
            const float v = uval * (o[dd][r] + bsv), vn = __shfl_xor(v, 1);
            if ((r32 & 1) == 0) *(unsigned*)(yb + (size_t)(tok0 + t) * DM + col) = pk2(v, vn); } }
    __syncthreads();
}
struct Args { const void* in[22]; float* out; unsigned char* ws; int ph_lo, ph_hi; };
__global__ void __launch_bounds__(NWAVES * 64, 2) fwd(Args args) {
    extern __shared__ __attribute__((aligned(16))) unsigned char lds_raw[];
    LAS unsigned char* lds = (LAS unsigned char*)lds_raw;
    volatile LAS unsigned* MISC = (volatile LAS unsigned*)(lds + MISC_OFF);
    const int tid = threadIdx.x, lane = tid & 63, wave = __builtin_amdgcn_readfirstlane(tid >> 6);
    const int G = gridDim.x, bx = blockIdx.x, vcu = (G % 8 == 0) ? (bx % 8) * (G / 8) + bx / 8 : bx;
    const int gw = vcu * NWAVES + wave, NGW = G * NWAVES;
    unsigned char* ws = (unsigned char*)karg_ptr(23); gu32* ctl = (gu32*)(ws + WS_CTL);
#define x_in ((const float*)karg_ptr(0))
#define p_in ((const float*)karg_ptr(1))
#define fox_w_in ((const float*)karg_ptr(2))
#define fox_b_f ((const float*)karg_ptr(3))
#define fox_w_o ((const float*)karg_ptr(4))
#define gm_w_in ((const float*)karg_ptr(5))
#define gm_ln_v_g ((const float*)karg_ptr(6))
#define gm_ln_v_b ((const float*)karg_ptr(7))
#define gm_w_s ((const float*)karg_ptr(8))
#define gm_b_s ((const float*)karg_ptr(9))
#define gm_w_o ((const float*)karg_ptr(10))
#define ffn_w_gu ((const float*)karg_ptr(11))
#define ffn_w_down ((const float*)karg_ptr(12))
#define moe_w_router ((const float*)karg_ptr(13))
#define moe_w_gu ((const float*)karg_ptr(14))
#define moe_w_down ((const float*)karg_ptr(15))
#define ln_mix_g ((const float*)karg_ptr(16))
#define ln_mix_b ((const float*)karg_ptr(17))
#define ln_ch_g ((const float*)karg_ptr(18))
#define ln_ch_b ((const float*)karg_ptr(19))
#define ple_w_proj ((const float*)karg_ptr(20))
#define ple_w_gate ((const float*)karg_ptr(21))
#define Wqkv ((bf16*)(ws + WS_WQKV))
#define Wo ((bf16*)(ws + WS_WO))
#define Wgu ((bf16*)(ws + WS_WGU))
#define Wdn ((bf16*)(ws + WS_WDN))
#define Wpg ((bf16*)(ws + WS_WPG))
#define Wpp ((bf16*)(ws + WS_WPP))
#define Wgmi ((bf16*)(ws + WS_WGMI))
#define Wsb ((bf16*)(ws + WS_WSB))
#define Wgmo ((bf16*)(ws + WS_WGMO))
#define Wmgu ((bf16*)(ws + WS_WMGU))
#define Wmdn ((bf16*)(ws + WS_WMDN))
#define X0B ((bf16*)(ws + WS_X0B))
#define QKV ((bf16*)(ws + WS_QKV))
#define OB ((bf16*)(ws + WS_O))
#define X1B ((bf16*)(ws + WS_X1B))
#define HB ((bf16*)(ws + WS_HB))
#define X2B ((bf16*)(ws + WS_X2B))
#define PW ((bf16*)(ws + WS_PW))
#define X3B ((bf16*)(ws + WS_X3B))
#define UV ((bf16*)(ws + WS_UV))
#define YB ((bf16*)(ws + WS_YB))
#define X4B ((bf16*)(ws + WS_X4B))
#define XS ((bf16*)(ws + WS_XS))
#define HM ((bf16*)(ws + WS_HM))
#define YS ((bf16*)(ws + WS_YS))
#define X5B ((bf16*)(ws + WS_X5B))
#define PB ((bf16*)(ws + WS_PB))
#define PRE ((float*)(ws + WS_PRE))
#define X1F ((float*)(ws + WS_X1F))
#define X2F ((float*)(ws + WS_X2F))
#define X3F ((float*)(ws + WS_X3F))
#define X4F ((float*)(ws + WS_X4F))
#define X5F ((float*)(ws + WS_X5F))
#define VSTAT ((float*)(ws + WS_VSTAT))
#define LOGF ((float*)(ws + WS_LOGF))
#define KBIAS ((float*)(ws + WS_KBIAS))
#define ROUTE (ws + WS_ROUTE)

    for (int u = tid; u < (LDS_BYTES - LDSCTL_OFF) / 4; u += NWAVES * 64) ((LAS unsigned*)(lds + LDSCTL_OFF))[u] = 0u;
    __syncthreads();
    constexpr bool ONE = (MK_N_LAUNCHES == 1);
    XcdBarrier bar; bar.bar = (unsigned*)(ctl + CW_BAR); bar.x = 0; bar.st = nullptr;
    if (ONE) bar = xcd_barrier_post((unsigned*)(ctl + CW_BAR), MISC + 8);
    const int lo = args.ph_lo, hi = args.ph_hi;
#ifndef PH_MASK
#define PH_MASK 0x3ffff
#endif
#define IN(k) (((PH_MASK >> (k)) & 1) && lo <= (k) && (k) < hi)
#define SEAM(k) do { if (ONE && IN((k) + 1)) xcd_barrier(bar); } while (0)
#define GEMM_CALL(EPI, ORD, g, S, E) pg8::gemm_phase<EPI, ORD, true, true>((PG8_LAS unsigned char*)lds, g, S, E)

    if (IN(0)) {
        p0_prologue(ws, lds, tid, lane, wave, vcu, G);
        SEAM(0);
    }
    if (IN(1)) {
        for (int s = vcu; s < NB * NH; s += G) cumsum_seq(LOGF, KBIAS, s, lds, tid, lane, wave);
        __syncthreads();
        { pg8::Gemm g{X0B, Wqkv, T, NQKV, DM}; pg8::StaticOrder S; S.init(T, NQKV, G, bx); pg8::EpiBf16S E{QKV, DM, DM, (size_t)T * DM}; GEMM_CALL(pg8::EpiBf16S, pg8::StaticOrder, g, S, E); }
        { pg8::Gemm g{PB, Wpp, T, DM, PD}; pg8::StaticOrder S; S.init(T, DM, G, bx); pg8::EpiBf16S E{PW, DM, 0, 0}; GEMM_CALL(pg8::EpiBf16S, pg8::StaticOrder, g, S, E); }
        { pg8::Gemm g{PB + (size_t)T * PD, Wpp + (size_t)DM * PD, T, DM, PD}; pg8::StaticOrder S; S.init(T, DM, G, bx); pg8::EpiBf16S E{PW + (size_t)T * DM, DM, 0, 0}; GEMM_CALL(pg8::EpiBf16S, pg8::StaticOrder, g, S, E); }
        SEAM(1);
    }
    if (IN(2)) {
        static_assert(fox::LDS_BYTES <= RING_BYTES, "attention LDS");
        fox::fox_phase((char*)lds_raw, (const fox::bf16*)QKV, (fox::bf16*)OB, KBIAS, vcu, G);
        SEAM(2);
    }
    if (IN(3)) {
        pg8::Gemm g{OB, Wo, T, DM, DM}; pg8::StaticOrder S; S.init(T, DM, G, bx); pg8::EpiResF32 E{x_in, PRE, DM, ALPHA}; GEMM_CALL(pg8::EpiResF32, pg8::StaticOrder, g, S, E);
        SEAM(3);
    }
    if (IN(4)) { ln_phase(PRE, ln_mix_g, ln_mix_b, X1F, X1B, lane, gw, NGW); SEAM(4); }
    if (IN(5)) {
        pg8::Gemm g{X1B, Wgu, T, 2 * FF, DM}; pg8::StaticOrder S; S.init(T, 2 * FF, G, bx); pg8::EpiSwiGLU E{HB, FF}; GEMM_CALL(pg8::EpiSwiGLU, pg8::StaticOrder, g, S, E);
        SEAM(5);
    }
    if (IN(6)) {
        pg8::Gemm g{HB, Wdn, T, DM, FF}; pg8::StaticOrder S; S.init(T, DM, G, bx); pg8::EpiResF32 E{X1F, PRE, DM, ALPHA}; GEMM_CALL(pg8::EpiResF32, pg8::StaticOrder, g, S, E);
        SEAM(6);
    }
    if (IN(7)) { ln_phase(PRE, ln_ch_g, ln_ch_b, X2F, X2B, lane, gw, NGW); SEAM(7); }
    if (IN(8)) {
        pg8::Gemm g{X2B, Wpg, T, DM, DM}; pg8::StaticOrder S; S.init(T, DM, G, bx); pg8::EpiPLE E{X2F, PW, X3F, X3B, DM}; GEMM_CALL(pg8::EpiPLE, pg8::StaticOrder, g, S, E);
        SEAM(8);
    }
    if (IN(9)) {
        pg8::Gemm g{X3B, Wgmi, T, 2 * DM, DM}; pg8::StaticOrder S; S.init(T, 2 * DM, G, bx); pg8::EpiGeluStats E{UV, 2 * DM, VSTAT, DM / 256}; GEMM_CALL(pg8::EpiGeluStats, pg8::StaticOrder, g, S, E);
        SEAM(9);
    }
    if (IN(10)) {
        for (int uid = vcu; uid < (T / GCH) * GG; uid += G) gating_unit(uid, UV, VSTAT, Wsb, gm_ln_v_g, gm_ln_v_b, gm_b_s, YB, lds, tid, lane, wave);
        SEAM(10);
    }
    if (IN(11)) {
        pg8::Gemm g{YB, Wgmo, T, DM, DM}; pg8::StaticOrder S; S.init(T, DM, G, bx); pg8::EpiResF32 E{X3F, PRE, DM, ALPHA}; GEMM_CALL(pg8::EpiResF32, pg8::StaticOrder, g, S, E);
        SEAM(11);
    }
    if (IN(12)) { ln_router_phase(PRE, ln_mix_g + DM, ln_mix_b + DM, X4F, X4B, moe_w_router, ROUTE, ctl, lds, tid, lane, gw, NGW); SEAM(12); }
    if (IN(13)) { moe_permute_phase(X4B, XS, ROUTE, ctl, lane, gw, NGW); SEAM(13); }
    if (IN(14)) {
        int ts[9], cnt[8]; moe_tiles(ctl, ts, cnt);
        pg8::Gemm g{XS, Wmgu, MOE_ROWS, 2 * FE, DM}; pg8::MoeOrder S; S.init(ts, 2 * FE / 256, G, bx); pg8::EpiSwiGLU E{HM, FE}; GEMM_CALL(pg8::EpiSwiGLU, pg8::MoeOrder, g, S, E);
        SEAM(14);
    }
    if (IN(15)) {
        int ts[9], cnt[8]; moe_tiles(ctl, ts, cnt);
        pg8::Gemm g{HM, Wmdn, MOE_ROWS, DM, FE}; pg8::MoeOrder S; S.init(ts, DM / 256, G, bx); pg8::EpiBf16S E{YS, DM, 0, 0}; GEMM_CALL(pg8::EpiBf16S, pg8::MoeOrder, g, S, E);
        SEAM(15);
    }
    if (IN(16)) { ln_moe_phase(X4F, YS, ln_ch_g + DM, ln_ch_b + DM, X5F, X5B, ROUTE, ctl, lane, gw, NGW); SEAM(16); }
    if (IN(17)) {
        pg8::Gemm g{X5B, Wpg + (size_t)DM * DM, T, DM, DM}; pg8::StaticOrder S; S.init(T, DM, G, bx); pg8::EpiPLE E{X5F, PW + (size_t)T * DM, (float*)karg_ptr(22), nullptr, DM}; GEMM_CALL(pg8::EpiPLE, pg8::StaticOrder, g, S, E);
    }
#undef IN
#undef SEAM
#undef GEMM_CALL
#undef x_in
#undef p_in
#undef fox_w_in
#undef fox_b_f
#undef fox_w_o
#undef gm_w_in
#undef gm_ln_v_g
#undef gm_ln_v_b
#undef gm_w_s
#undef gm_b_s
#undef gm_w_o
#undef ffn_w_gu
#undef ffn_w_down
#undef moe_w_router
#undef moe_w_gu
#undef moe_w_down
#undef ln_mix_g
#undef ln_mix_b
#undef ln_ch_g
#undef ln_ch_b
#undef ple_w_proj
#undef ple_w_gate
#undef Wqkv
#undef Wo
#undef Wgu
#undef Wdn
#undef Wpg
#undef Wpp
#undef Wgmi
#undef Wsb
#undef Wgmo
#undef Wmgu
#undef Wmdn
#undef X0B
#undef QKV
#undef OB
#undef X1B
#undef HB
#undef X2B
#undef PW
#undef X3B
#undef UV
#undef YB
#undef X4B
#undef XS
#undef HM
#undef YS
#undef X5B
#undef PB
#undef PRE
#undef X1F
#undef X2F
#undef X3F
#undef X4F
#undef X5F
#undef VSTAT
#undef LOGF
#undef KBIAS
#undef ROUTE
}

extern "C" void kernel_launch(void* const* d_in, const int* in_sizes, int n_in, void* d_out, int out_size, void* d_ws, size_t ws_size, hipStream_t stream) {
    static int grid = 0;
    if (grid == 0) {
        if (n_in != 22 || in_sizes[0] != T * DM || out_size != T * DM || ws_size < WS_END) {
            fprintf(stderr, "kernel_launch: built for 22 inputs, x/out of %d floats, >= %zu bytes of workspace; got n_in %d, in0 %d, out %d, ws %zu; nothing launched\n", T * DM, (size_t)WS_END, n_in, n_in > 0 ? in_sizes[0] : -1, out_size, ws_size);
            grid = -1; return; }
        int dev = 0, cus = 0, per_cu = 0;
        if (hipGetDevice(&dev) != hipSuccess || hipDeviceGetAttribute(&cus, hipDeviceAttributeMultiprocessorCount, dev) != hipSuccess) { fprintf(stderr, "kernel_launch: device query failed\n"); grid = -1; return; }
        if (hipFuncSetAttribute((const void*)fwd, hipFuncAttributeMaxDynamicSharedMemorySize, LDS_BYTES) != hipSuccess) { fprintf(stderr, "kernel_launch: hipFuncSetAttribute failed\n"); grid = -1; return; }
        if (hipOccupancyMaxActiveBlocksPerMultiprocessor(&per_cu, (const void*)fwd, NWAVES * 64, LDS_BYTES) != hipSuccess || per_cu < 1)
            fprintf(stderr, "kernel_launch: note: occupancy query reports %d workgroups per CU\n", per_cu);
        (void)hipGetLastError();
        grid = cus;
    }
    if (grid < 0) return;
    if (hipMemsetAsync((char*)d_ws + WS_CTL, 0, CTL_ZERO_BYTES, stream) != hipSuccess) { fprintf(stderr, "kernel_launch: memset failed\n"); return; }
    Args a{};
    for (int i = 0; i < 22; ++i) a.in[i] = d_in[i];
    a.out = (float*)d_out; a.ws = (unsigned char*)d_ws;
    for (int li = 0; li < MK_N_LAUNCHES; ++li) {
        a.ph_lo = (MK_N_LAUNCHES == 1) ? 0 : li; a.ph_hi = (MK_N_LAUNCHES == 1) ? N_PHASES : li + 1;
        hipLaunchKernelGGL(fwd, dim3(grid), dim3(NWAVES * 64), LDS_BYTES, stream, a);
        const hipError_t le = hipPeekAtLastError();
        if (le != hipSuccess) { fprintf(stderr, "kernel_launch: launch %d failed: %s\n", li, hipGetErrorName(le)); break; }
    }
}
```

```cpp
#include <hip/hip_runtime.h>
#include <hip/hip_bf16.h>
#include <cstdio>
#include <cstdint>
namespace pg8 {
#define PG8_LAS __attribute__((address_space(3)))
typedef unsigned short bf16_t;
typedef short bf16x8 __attribute__((ext_vector_type(8)));
typedef float f32x4 __attribute__((ext_vector_type(4)));
typedef unsigned u32x4 __attribute__((ext_vector_type(4)));
typedef int i32x4_t __attribute__((ext_vector_type(4)));
typedef int i32x8_t __attribute__((ext_vector_type(8)));
constexpr int BM = 256, BK = 64, HALF = 128, HTB = HALF * BK * 2  , STAGE_BYTES = 8 * HTB, NXCD = 8, WGM = 8;

__host__ __device__ __forceinline__ int lds_byte(int r, int c) { const int st = (r >> 4) * 2 + (c >> 5), rr = r & 15, cc = c & 31, ob = rr * 64 + cc * 2; return st * 1024 + (ob ^ (((ob >> 9) & 1) << 5)); }
__host__ __device__ __forceinline__ void stage_rc(int b, int& R, int& C) { const int st = b / 1024, sb = b % 1024, swz = sb ^ (((sb >> 9) & 1) << 5); R = (st >> 1) * 16 + swz / 64; C = (st & 1) * 32 + (swz % 64) / 2; }
__host__ __device__ __forceinline__ int perm32(int rho) { const int n = rho >> 4, i = rho & 15; return 8 * (i >> 2) + 4 * n + (i & 3); }

struct Unit { int pm, pn, pb; };
struct Gemm { const bf16_t* A; const bf16_t* Bt; int M, N, K; };

struct StaticOrder {
    int nM, nN, nwg, G, c;
    __host__ __device__ void init(int M, int N, int G_, int c_) { nM = M / BM; nN = N / BM; nwg = nM * nN; G = G_; c = c_; }
    __host__ __device__ bool next(int i, Unit& u) const {
        const long L = (long)i * G + c; if (L >= nwg) return false;
        int wgid = (int)L; { const int q = nwg / NXCD, r = nwg % NXCD, xcd = wgid % NXCD, off = wgid / NXCD; wgid = (xcd < r ? xcd * (q + 1) : r * (q + 1) + (xcd - r) * q) + off; }
        const int nig = WGM * nN, gid = wgid / nig, fm = gid * WGM, gsz = (nM - fm) < WGM ? (nM - fm) : WGM;
        u.pm = fm + ((wgid % nig) % gsz); u.pn = (wgid % nig) / gsz; u.pb = u.pn; return true;
    }
    __device__ __forceinline__ void a_ready(const Unit&) const {}
    __device__ __forceinline__ void done(const Unit&) const {}
};

__device__ __forceinline__ unsigned cvt_pk_bf16(float lo, float hi) { unsigned r; asm volatile("v_cvt_pk_bf16_f32 %0, %1, %2" : "=v"(r) : "v"(lo), "v"(hi)); return r; }
typedef float f32x2 __attribute__((ext_vector_type(2)));
typedef float f32x2 __attribute__((ext_vector_type(2)));
typedef unsigned u32x2 __attribute__((ext_vector_type(2)));
__device__ __forceinline__ float fast_sigmoid(float a) { return __builtin_amdgcn_rcpf(1.0f + __builtin_amdgcn_exp2f(-1.4426950408889634f * a)); }
__device__ __forceinline__ float gelu_tanh(float x) { const float u = x * (1.0f + 0.044715f * x * x); return x * __builtin_amdgcn_rcpf(1.0f + __builtin_amdgcn_exp2f(-2.3022081985f * u)); }
__device__ __forceinline__ float bf_lo(unsigned w) { return __uint_as_float(w << 16); }
__device__ __forceinline__ float bf_hi(unsigned w) { return __uint_as_float(w & 0xffff0000u); }

struct EpiBf16S {
    static constexpr bool PERM = true, AFTER_DRAIN = false;
    bf16_t* O; int ldc; int split_cols; size_t split_stride; float scale;
    __device__ __forceinline__ void operator()(const f32x4 (&acc)[2][2][4][2], const Unit& u, int wr, int wc, int fr, int fq) const {
        const int row0 = u.pm * BM + wr * 64 + fr; int colt = u.pn * BM; bf16_t* base = O;
        if (split_cols) { const int t = colt / split_cols; base += (size_t)t * split_stride; colt -= t * split_cols; }
        const int col0 = colt + wc * 32 + 8 * fq;
#pragma unroll
        for (int ai = 0; ai < 2; ++ai)
#pragma unroll
            for (int m = 0; m < 4; ++m) { bf16_t* rowp = base + (size_t)(row0 + ai * HALF + m * 16) * ldc + col0;
#pragma unroll
                for (int bj = 0; bj < 2; ++bj) { const f32x4 v0 = acc[ai][bj][m][0] * scale, v1 = acc[ai][bj][m][1] * scale;
                    u32x4 w; w.x = cvt_pk_bf16(v0[0], v0[1]); w.y = cvt_pk_bf16(v0[2], v0[3]); w.z = cvt_pk_bf16(v1[0], v1[1]); w.w = cvt_pk_bf16(v1[2], v1[3]);
                    *(u32x4*)(rowp + bj * HALF) = w; } }
    }
};
struct EpiGeluStats {
    static constexpr bool PERM = true, AFTER_DRAIN = false;
    bf16_t* O; int ldc; float* stat; int vt0;
    __device__ __forceinline__ void operator()(const f32x4 (&acc)[2][2][4][2], const Unit& u, int wr, int wc, int fr, int fq) const {
        const int row0 = u.pm * BM + wr * 64 + fr; const int col0 = u.pn * BM + wc * 32 + 8 * fq;
        const bool isv = u.pn >= vt0;
#pragma unroll
        for (int ai = 0; ai < 2; ++ai)
#pragma unroll
            for (int m = 0; m < 4; ++m) { const int row = row0 + ai * HALF + m * 16; bf16_t* rowp = O + (size_t)row * ldc + col0; float s = 0.f, q = 0.f;
#pragma unroll
                for (int bj = 0; bj < 2; ++bj) { f32x4 v0 = acc[ai][bj][m][0], v1 = acc[ai][bj][m][1];
#pragma unroll
                    for (int e = 0; e < 4; ++e) { v0[e] = gelu_tanh(v0[e]); v1[e] = gelu_tanh(v1[e]); s += v0[e] + v1[e]; q += v0[e] * v0[e] + v1[e] * v1[e]; }
                    u32x4 w; w.x = cvt_pk_bf16(v0[0], v0[1]); w.y = cvt_pk_bf16(v0[2], v0[3]); w.z = cvt_pk_bf16(v1[0], v1[1]); w.w = cvt_pk_bf16(v1[2], v1[3]);
                    *(u32x4*)(rowp + bj * HALF) = w; }
                if (isv) { s += __shfl_xor(s, 16); s += __shfl_xor(s, 32); q += __shfl_xor(q, 16); q += __shfl_xor(q, 32);
                    if (fq == 0) *(f32x2*)(stat + ((size_t)row * 32 + (u.pn - vt0) * 4 + wc) * 2) = (f32x2){s, q}; } }
    }
};
struct EpiSwiGLU {
    static constexpr bool PERM = true, AFTER_DRAIN = false;
    bf16_t* O; int ldc;
    __device__ __forceinline__ void operator()(const f32x4 (&acc)[2][2][4][2], const Unit& u, int wr, int wc, int fr, int fq) const {
        const int row0 = u.pm * BM + wr * 64 + fr; const int col0 = u.pn * HALF + wc * 32 + 8 * fq;
#pragma unroll
        for (int ai = 0; ai < 2; ++ai)
#pragma unroll
            for (int m = 0; m < 4; ++m) { bf16_t* rowp = O + (size_t)(row0 + ai * HALF + m * 16) * ldc + col0;
                f32x4 h0, h1;
#pragma unroll
                for (int e = 0; e < 4; ++e) { const float g0 = acc[ai][0][m][0][e], g1 = acc[ai][0][m][1][e];
                    h0[e] = g0 * fast_sigmoid(g0) * acc[ai][1][m][0][e]; h1[e] = g1 * fast_sigmoid(g1) * acc[ai][1][m][1][e]; }
                u32x4 w; w.x = cvt_pk_bf16(h0[0], h0[1]); w.y = cvt_pk_bf16(h0[2], h0[3]); w.z = cvt_pk_bf16(h1[0], h1[1]); w.w = cvt_pk_bf16(h1[2], h1[3]);
                *(u32x4*)rowp = w; }
    }
};
__device__ __forceinline__ unsigned pk4_fp8(float a, float b, float c, float d) {
    a = __builtin_amdgcn_fmed3f(a, -448.f, 448.f); b = __builtin_amdgcn_fmed3f(b, -448.f, 448.f); c = __builtin_amdgcn_fmed3f(c, -448.f, 448.f); d = __builtin_amdgcn_fmed3f(d, -448.f, 448.f);
    int w = __builtin_amdgcn_cvt_pk_fp8_f32(a, b, 0, false); w = __builtin_amdgcn_cvt_pk_fp8_f32(c, d, w, true); return (unsigned)w; }
struct EpiSwiGLU8 {
    static constexpr bool PERM = true, AFTER_DRAIN = false;
    unsigned char* O; int ldc; float inv, so;
    __device__ __forceinline__ void operator()(const f32x4 (&acc)[2][2][4][2], const Unit& u, int wr, int wc, int fr, int fq) const {
        const int row0 = u.pm * BM + wr * 64 + fr; const int col0 = u.pn * HALF + wc * 32 + 8 * fq;
#pragma unroll
        for (int ai = 0; ai < 2; ++ai)
#pragma unroll
            for (int m = 0; m < 4; ++m) { unsigned char* rowp = O + (size_t)(row0 + ai * HALF + m * 16) * ldc + col0;
                f32x4 h0, h1;
#pragma unroll
                for (int e = 0; e < 4; ++e) { const float g0 = acc[ai][0][m][0][e] * inv, g1 = acc[ai][0][m][1][e] * inv;
                    h0[e] = g0 * fast_sigmoid(g0) * (acc[ai][1][m][0][e] * (inv * so)); h1[e] = g1 * fast_sigmoid(g1) * (acc[ai][1][m][1][e] * (inv * so)); }
                u32x2 w; w.x = pk4_fp8(h0[0], h0[1], h0[2], h0[3]); w.y = pk4_fp8(h1[0], h1[1], h1[2], h1[3]);
                *(u32x2*)rowp = w; }
    }
};
struct EpiResF32 {
    static constexpr bool PERM = false, AFTER_DRAIN = false;
    const float* base; float* out; int ldc; float alpha;
    __device__ __forceinline__ void operator()(const f32x4 (&acc)[2][2][4][2], const Unit& u, int wr, int wc, int fr, int fq) const {
        const int row0 = u.pm * BM + wr * 64 + fr; const int col0 = u.pn * BM + wc * 32 + 4 * fq;
#pragma unroll
        for (int ai = 0; ai < 2; ++ai)
#pragma unroll
            for (int m = 0; m < 4; ++m) { const size_t off = (size_t)(row0 + ai * HALF + m * 16) * ldc + col0;
#pragma unroll
                for (int bj = 0; bj < 2; ++bj)
#pragma unroll
                    for (int n = 0; n < 2; ++n) { const f32x4 b = *(const f32x4*)(base + off + bj * HALF + n * 16); *(f32x4*)(out + off + bj * HALF + n * 16) = b * alpha + acc[ai][bj][m][n]; } }
    }
};
struct EpiPLE {
    static constexpr bool PERM = false, AFTER_DRAIN = false;
    const float* x; const bf16_t* pw; float* outF; bf16_t* outB; int ldc;
    __device__ __forceinline__ void operator()(const f32x4 (&acc)[2][2][4][2], const Unit& u, int wr, int wc, int fr, int fq) const {
        const int row0 = u.pm * BM + wr * 64 + fr; const int col0 = u.pn * BM + wc * 32 + 4 * fq;
#pragma unroll
        for (int ai = 0; ai < 2; ++ai)
#pragma unroll
            for (int m = 0; m < 4; ++m) { const size_t off = (size_t)(row0 + ai * HALF + m * 16) * ldc + col0;
#pragma unroll
                for (int bj = 0; bj < 2; ++bj)
#pragma unroll
                    for (int n = 0; n < 2; ++n) { const size_t o2 = off + bj * HALF + n * 16; const f32x4 xv = *(const f32x4*)(x + o2); const u32x2 pv = *(const u32x2*)(pw + o2);
                        const f32x4 a = acc[ai][bj][m][n]; f32x4 o;
                        o[0] = xv[0] + fast_sigmoid(a[0]) * bf_lo(pv.x); o[1] = xv[1] + fast_sigmoid(a[1]) * bf_hi(pv.x);
                        o[2] = xv[2] + fast_sigmoid(a[2]) * bf_lo(pv.y); o[3] = xv[3] + fast_sigmoid(a[3]) * bf_hi(pv.y);
                        *(f32x4*)(outF + o2) = o;
                        if (outB) { u32x2 w; w.x = cvt_pk_bf16(o[0], o[1]); w.y = cvt_pk_bf16(o[2], o[3]); *(u32x2*)(outB + o2) = w; } } }
    }
};
struct MoeOrder {
    int t[9]; int nN, nwg, G, c;
    __device__ __forceinline__ void init(const int (&ts_)[9], int nN_, int G_, int c_) {
#pragma unroll
        for (int j = 0; j < 9; ++j) t[j] = ts_[j];
        nN = nN_; G = G_; c = c_; nwg = t[8] * nN_; }
    __device__ __forceinline__ bool next(int i, Unit& u) const {
        const long L = (long)i * G + c; if (L >= nwg) return false;
        int wgid = (int)L; { const int q = nwg / NXCD, r = nwg % NXCD, xcd = wgid % NXCD, off = wgid / NXCD; wgid = (xcd < r ? xcd * (q + 1) : r * (q + 1) + (xcd - r) * q) + off; }
        int t0 = t[0], t1 = t[1], e = 0;
#pragma unroll
        for (int j = 1; j < 8; ++j) if (wgid >= t[j] * nN) { t0 = t[j]; t1 = t[j + 1]; e = j; }
        const int nt = t1 - t0, loc = wgid - t0 * nN;
        u.pm = t0 + loc % nt; u.pn = loc / nt; u.pb = e * nN + u.pn; return true;
    }
    __device__ __forceinline__ void a_ready(const Unit&) const {}
    __device__ __forceinline__ void done(const Unit&) const {}
};
template <class Epi, class Sched, bool ALIGN_EPI = false, bool SP2 = false, bool F8 = false>
__device__ __forceinline__ void gemm_phase(PG8_LAS unsigned char* lds, const Gemm g, const Sched& S, const Epi& E) {
    const int tid = threadIdx.x, wid = __builtin_amdgcn_readfirstlane(tid >> 6), lane = tid & 63, wr = wid >> 2, wc = wid & 3, fr = lane & 15, fq = lane >> 4;
    const int K = g.K, nt = K / BK;
    unsigned voffA[2], voffB[2];
#pragma unroll
    for (int i = 0; i < 2; ++i) { int R, C; stage_rc(tid * 16 + i * 8192, R, C); const int Rb = Epi::PERM ? ((R & ~31) + perm32(R & 31)) : R;
        voffA[i] = (unsigned)(R * K + C) * 2u; voffB[i] = (unsigned)(Rb * K + C) * 2u; }
    const size_t kstep = (size_t)(BK * 2);
    const size_t hstep = (size_t)HALF * K * 2;
    const size_t tstep = 2 * hstep;
    const unsigned ldsw = (unsigned)wid * 1024u;
    const int aoff = lds_byte(wr * 64 + fr, fq * 8), boff = lds_byte(wc * 32 + fr, fq * 8);
#define PG8_SA(b, h) (((b) * 2 + (h)) * HTB)
#define PG8_SB(b, h) ((4 + (b) * 2 + (h)) * HTB)
#define PG8_STAGE(bufoff, gbase, voff) do { _Pragma("unroll") for (int _i = 0; _i < 2; ++_i) \
        __builtin_amdgcn_global_load_lds((const unsigned*)((const char*)(gbase) + (voff)[_i]), (PG8_LAS unsigned*)(lds + (bufoff) + ldsw + _i * 8192), 16, 0, 0); } while (0)
#define PG8_LDA(dst, b, h) do { _Pragma("unroll") for (int m = 0; m < 4; ++m) { \
        if constexpr (F8) { const i32x4_t lo_ = *(const PG8_LAS i32x4_t*)(lds + PG8_SA(b, h) + aoff + m * 2048), hi_ = *(const PG8_LAS i32x4_t*)(lds + PG8_SA(b, h) + aoff + m * 2048 + 1024); \
                            dst##8[m] = __builtin_shufflevector(lo_, hi_, 0, 1, 2, 3, 4, 5, 6, 7); } \
        else { _Pragma("unroll") for (int k = 0; k < 2; ++k) dst[m][k] = *(const PG8_LAS bf16x8*)(lds + PG8_SA(b, h) + aoff + m * 2048 + k * 1024); } } } while (0)
#define PG8_LDB(dst, b, h) do { _Pragma("unroll") for (int n = 0; n < 2; ++n) { \
        if constexpr (F8) { const i32x4_t lo_ = *(const PG8_LAS i32x4_t*)(lds + PG8_SB(b, h) + boff + n * 2048), hi_ = *(const PG8_LAS i32x4_t*)(lds + PG8_SB(b, h) + boff + n * 2048 + 1024); \
                            dst##8[n] = __builtin_shufflevector(lo_, hi_, 0, 1, 2, 3, 4, 5, 6, 7); } \
        else { _Pragma("unroll") for (int k = 0; k < 2; ++k) dst[n][k] = *(const PG8_LAS bf16x8*)(lds + PG8_SB(b, h) + boff + n * 2048 + k * 1024); } } } while (0)
#define PG8_MMA(ai, bj, At, Bt) do { __builtin_amdgcn_s_setprio(1); _Pragma("unroll") for (int m = 0; m < 4; ++m) _Pragma("unroll") for (int n = 0; n < 2; ++n) { \
        if constexpr (F8) asm volatile("v_mfma_f32_16x16x128_f8f6f4 %0, %1, %2, %0" : "+v"(acc[ai][bj][m][n]) : "v"(Bt##8[n]), "v"(At##8[m]));   \
        else { _Pragma("unroll") for (int k = 0; k < 2; ++k) acc[ai][bj][m][n] = __builtin_amdgcn_mfma_f32_16x16x32_bf16(Bt[n][k], At[m][k], acc[ai][bj][m][n], 0, 0, 0); } } \
        __builtin_amdgcn_s_setprio(0); } while (0)
#define PG8_WAIT_V(n) asm volatile("s_waitcnt vmcnt(" #n ")" ::: "memory")
#define PG8_WAIT_L(n) asm volatile("s_waitcnt lgkmcnt(" #n ")" ::: "memory")
#define PG8_BAR __builtin_amdgcn_s_barrier()
#define PG8_SCHED __builtin_amdgcn_sched_barrier(0)
    Unit cur, nxt; int ui = 0;
    if (!S.next(0, cur)) return;
    f32x4 acc[2][2][4][2];
#pragma unroll
    for (int a = 0; a < 2; ++a)
#pragma unroll
        for (int b = 0; b < 2; ++b)
#pragma unroll
            for (int m = 0; m < 4; ++m)
#pragma unroll
                for (int n = 0; n < 2; ++n) acc[a][b][m][n] = (f32x4){0.f, 0.f, 0.f, 0.f};
    bf16x8 At[4][2], B0[2][2], B1[2][2];
    i32x8_t At8[4], B08[2], B18[2];
    const char* cA = (const char*)g.A + (size_t)cur.pm * tstep; const char* cB = (const char*)g.Bt + (size_t)cur.pb * tstep;
    S.a_ready(cur);
    if constexpr (SP2) {
        PG8_STAGE(PG8_SB(0, 0), cB, voffB); PG8_STAGE(PG8_SB(0, 1), cB + hstep, voffB); PG8_STAGE(PG8_SA(0, 0), cA, voffA); PG8_STAGE(PG8_SA(0, 1), cA + hstep, voffA);
        if (wr == 1) PG8_BAR;
        PG8_WAIT_V(2); PG8_BAR;
        PG8_STAGE(PG8_SB(1, 0), cB + kstep, voffB); PG8_STAGE(PG8_SA(1, 0), cA + kstep, voffA); PG8_STAGE(PG8_SB(1, 1), cB + hstep + kstep, voffB);
        PG8_WAIT_V(6); PG8_BAR;
    } else {
        PG8_STAGE(PG8_SB(0, 0), cB, voffB); PG8_STAGE(PG8_SA(0, 0), cA, voffA); PG8_STAGE(PG8_SB(0, 1), cB + hstep, voffB); PG8_STAGE(PG8_SA(0, 1), cA + hstep, voffA);
        if (wr == 1) PG8_BAR;
        PG8_WAIT_V(4); PG8_BAR;
        PG8_STAGE(PG8_SB(1, 0), cB + kstep, voffB); PG8_STAGE(PG8_SA(1, 0), cA + kstep, voffA); PG8_STAGE(PG8_SB(1, 1), cB + hstep + kstep, voffB);
        PG8_WAIT_V(6); PG8_BAR;
    }
    for (;;) {
        const bool has_next = S.next(ui + 1, nxt);
        const char* nA = has_next ? (const char*)g.A + (size_t)nxt.pm * tstep : cA; const char* nB = has_next ? (const char*)g.Bt + (size_t)nxt.pb * tstep : cB;
        for (int t = 0; t < nt; t += 2) {
            const bool last = (t == nt - 2);
            const char* a1 = cA + (size_t)(t + 1) * kstep;
            const char* a2 = last ? nA : cA + (size_t)(t + 2) * kstep; const char* b2 = last ? nB : cB + (size_t)(t + 2) * kstep;
            const char* a3 = a2 + kstep; const char* b3 = b2 + kstep;
            if (last && has_next) S.a_ready(nxt);
            if constexpr (SP2) {
            PG8_LDB(B0, 0, 0); PG8_LDB(B1, 0, 1); PG8_SCHED; PG8_LDA(At, 0, 0); PG8_STAGE(PG8_SA(1, 1), a1 + hstep, voffA);
            PG8_WAIT_V(8); PG8_WAIT_L(0); PG8_BAR; PG8_MMA(0, 0, At, B0); PG8_MMA(0, 1, At, B1); PG8_BAR; PG8_SCHED;
            PG8_LDA(At, 0, 1); PG8_STAGE(PG8_SB(0, 0), b2, voffB); PG8_STAGE(PG8_SB(0, 1), b2 + hstep, voffB); PG8_STAGE(PG8_SA(0, 0), a2, voffA);
            PG8_WAIT_V(8); PG8_WAIT_L(0); PG8_BAR; PG8_MMA(1, 0, At, B0); PG8_MMA(1, 1, At, B1); PG8_BAR; PG8_SCHED;
            PG8_LDB(B0, 1, 0); PG8_LDB(B1, 1, 1); PG8_SCHED; PG8_LDA(At, 1, 0); PG8_STAGE(PG8_SA(0, 1), a2 + hstep, voffA);
            PG8_WAIT_V(8); PG8_WAIT_L(0); PG8_BAR; PG8_MMA(0, 0, At, B0); PG8_MMA(0, 1, At, B1); PG8_BAR; PG8_SCHED;
            PG8_LDA(At, 1, 1); PG8_STAGE(PG8_SB(1, 0), b3, voffB); PG8_STAGE(PG8_SB(1, 1), b3 + hstep, voffB); PG8_STAGE(PG8_SA(1, 0), a3, voffA);
            PG8_WAIT_V(8); PG8_WAIT_L(0); PG8_BAR; PG8_MMA(1, 0, At, B0); PG8_MMA(1, 1, At, B1); PG8_BAR; PG8_SCHED;
            } else {
            PG8_LDB(B0, 0, 0); PG8_SCHED; PG8_LDA(At, 0, 0); PG8_STAGE(PG8_SA(1, 1), a1 + hstep, voffA);
            PG8_WAIT_L(8); PG8_BAR; PG8_WAIT_L(0); PG8_MMA(0, 0, At, B0); PG8_BAR; PG8_SCHED;
            PG8_LDB(B1, 0, 1); PG8_STAGE(PG8_SB(0, 0), b2, voffB);
            PG8_BAR; PG8_WAIT_L(0); PG8_MMA(0, 1, At, B1); PG8_BAR;
            PG8_LDA(At, 0, 1); PG8_STAGE(PG8_SA(0, 0), a2, voffA);
            PG8_BAR; PG8_WAIT_L(0); PG8_MMA(1, 0, At, B0); PG8_BAR; PG8_SCHED;
            PG8_STAGE(PG8_SB(0, 1), b2 + hstep, voffB);
            PG8_WAIT_V(6); PG8_BAR; PG8_MMA(1, 1, At, B1); PG8_BAR;
            PG8_LDB(B0, 1, 0); PG8_SCHED; PG8_LDA(At, 1, 0); PG8_STAGE(PG8_SA(0, 1), a2 + hstep, voffA);
            PG8_WAIT_L(8); PG8_BAR; PG8_WAIT_L(0); PG8_MMA(0, 0, At, B0); PG8_BAR; PG8_SCHED;
            PG8_LDB(B1, 1, 1); PG8_STAGE(PG8_SB(1, 0), b3, voffB);
            PG8_BAR; PG8_WAIT_L(0); PG8_MMA(0, 1, At, B1); PG8_BAR;
            PG8_LDA(At, 1, 1); PG8_STAGE(PG8_SA(1, 0), a3, voffA);
            PG8_BAR; PG8_WAIT_L(0); PG8_MMA(1, 0, At, B0); PG8_BAR; PG8_SCHED;
            PG8_STAGE(PG8_SB(1, 1), b3 + hstep, voffB);
            PG8_WAIT_V(6); PG8_BAR; PG8_MMA(1, 1, At, B1); PG8_BAR;
            }
        }
        if constexpr (ALIGN_EPI) { if (wr == 0) PG8_BAR; }
        if constexpr (F8) asm volatile("s_nop 15\n\ts_nop 7" ::: "memory");
        if constexpr (!Epi::AFTER_DRAIN) { E(acc, cur, wr, wc, fr, fq); S.done(cur); }
        if (!has_next) break;
#pragma unroll
        for (int a = 0; a < 2; ++a)
#pragma unroll
            for (int b = 0; b < 2; ++b)
#pragma unroll
                for (int m = 0; m < 4; ++m)
#pragma unroll
                    for (int n = 0; n < 2; ++n) acc[a][b][m][n] = (f32x4){0.f, 0.f, 0.f, 0.f};
        cur = nxt; cA = nA; cB = nB; ++ui;
        if constexpr (ALIGN_EPI) { if (wr == 1) PG8_BAR; }
    }
    PG8_WAIT_V(0);
    if constexpr (!ALIGN_EPI) { if (wr == 0) PG8_BAR; }
    PG8_BAR;
    if constexpr (Epi::AFTER_DRAIN) { E.fused(acc, cur, wr, wc, fr, fq, lds, wid, lane); S.done(cur); }
#undef PG8_SA
#undef PG8_SB
#undef PG8_STAGE
#undef PG8_LDA
#undef PG8_LDB
#undef PG8_MMA
#undef PG8_WAIT_V
#undef PG8_WAIT_L
#undef PG8_BAR
#undef PG8_SCHED
}
}
namespace fox {
#define FLAS __attribute__((address_space(3)))
using bf16 = __hip_bfloat16;
typedef short bf16x8 __attribute__((ext_vector_type(8)));
typedef short s16x4 __attribute__((ext_vector_type(4)));
typedef float f32x16 __attribute__((ext_vector_type(16)));
typedef float f32x4 __attribute__((ext_vector_type(4)));
typedef unsigned u32x4 __attribute__((ext_vector_type(4)));
constexpr int D = 128, PITCH = 2048, SQ = 4096, NHD = 16;
constexpr float SCALE = 0.08838834764831845f;
constexpr float THR2 = 11.5415603f;
constexpr int NW = 8, QBLK = 32, KVBLK = 64, QB = NW * QBLK;
constexpr int SHM_V = KVBLK * D * 2, SHM_K = KVBLK * D * 2;
constexpr int OFF_WS = 2 * SHM_V + 2 * SHM_K, OFF_KB = OFF_WS + NW * 64 * 4, LDS_BYTES = OFF_KB + SQ * 4;
#define KSWZ(row, colB) ((row) * 256 + ((colB) ^ (((row) & 7) << 4)))
#define SBAR() __builtin_amdgcn_sched_barrier(0)
__device__ __forceinline__ int v_st(int k, int c) { const int kk = (k & ~0xC) | ((k & 4) << 1) | ((k & 8) >> 1); return ((kk >> 3) * 4 + (c >> 5)) * 512 + ((kk & 7) * 32 + (c & 31)) * 2; }
__device__ __forceinline__ int v_rd_base(int lane) { return ((lane & 3) << 3) | (((lane >> 2) & 3) << 6) | (((lane >> 4) & 1) << 5) | (((lane >> 5) & 1) << 8); }
constexpr int v_rd_off(int d0, int ks, int half) { return d0 * 512 + ks * 4096 + half * 2048; }
__device__ __forceinline__ int crow(int r, int hi) { return (r & 3) + 8 * (r >> 2) + 4 * hi; }
__device__ __forceinline__ unsigned cvtpk(float lo, float hi) { unsigned r; asm volatile("v_cvt_pk_bf16_f32 %0, %1, %2" : "=v"(r) : "v"(lo), "v"(hi)); return r; }
__device__ __forceinline__ bf16x8 load8(const bf16* p) { return *reinterpret_cast<const bf16x8*>(p); }
__device__ __forceinline__ void mask_tile(f32x16& p0, f32x16& p1, int dq) {
    const float NEG = -__builtin_inff();
#pragma unroll
    for (int r = 0; r < 16; ++r) { const int c = (r & 3) + 8 * (r >> 2); if (dq - c < 0) p0[r] = NEG; if (dq - c - 32 < 0) p1[r] = NEG; }
}
__device__ __forceinline__ void partialSM(f32x16& p0, f32x16& p1, const FLAS char* kbp, bool domask, int dq, float& m_reg, float& mn, float& alpha) {
    constexpr float C2 = 1.4426950408889634f * SCALE;
#pragma unroll
    for (int j = 0; j < 4; ++j) { const f32x4 b0 = *(const FLAS f32x4*)(kbp + j * 32), b1 = *(const FLAS f32x4*)(kbp + 128 + j * 32);
#pragma unroll
        for (int e = 0; e < 4; ++e) { p0[4 * j + e] = fmaf(p0[4 * j + e], C2, b0[e]); p1[4 * j + e] = fmaf(p1[4 * j + e], C2, b1[e]); } }
    if (domask) mask_tile(p0, p1, dq);
    float pmax = p0[0];
#pragma unroll
    for (int r = 1; r < 16; ++r) pmax = fmaxf(pmax, p0[r]);
#pragma unroll
    for (int r = 0; r < 16; ++r) pmax = fmaxf(pmax, p1[r]);
    { auto rr = __builtin_amdgcn_permlane32_swap(__float_as_uint(pmax), __float_as_uint(pmax), false, false);
      pmax = fmaxf(__uint_as_float(rr[0]), __uint_as_float(rr[1])); }
    if (__builtin_expect(__all(pmax - m_reg <= THR2), 1)) { mn = m_reg; alpha = 1.f; }
    else { mn = fmaxf(m_reg, pmax); alpha = __builtin_amdgcn_exp2f(m_reg - mn); m_reg = mn; }
#pragma unroll
    for (int r = 0; r < 16; ++r) p0[r] = p0[r] - mn;
#pragma unroll
    for (int r = 0; r < 16; ++r) p1[r] = p1[r] - mn;
#pragma unroll
    for (int r = 0; r < 16; ++r) p0[r] = __builtin_amdgcn_exp2f(p0[r]);
}
__device__ __forceinline__ void finishSM(f32x16& p0, f32x16& p1, float alpha, float& l_reg, bf16x8& pa0, bf16x8& pa1, bf16x8& pa2, bf16x8& pa3) {
#pragma unroll
    for (int r = 0; r < 16; ++r) p1[r] = __builtin_amdgcn_exp2f(p1[r]);
    float ps = 0;
#pragma unroll
    for (int r = 0; r < 16; ++r) ps += p0[r];
#pragma unroll
    for (int r = 0; r < 16; ++r) ps += p1[r];
    { auto rr = __builtin_amdgcn_permlane32_swap(__float_as_uint(ps), __float_as_uint(ps), false, false);
      ps = __uint_as_float(rr[0]) + __uint_as_float(rr[1]); }
    l_reg = l_reg * alpha + ps;
#define PK4(P, B_, OUT) do { unsigned a0 = cvtpk(P[B_+0], P[B_+1]), a1 = cvtpk(P[B_+2], P[B_+3]);                          \
        unsigned b0 = cvtpk(P[B_+4], P[B_+5]), b1 = cvtpk(P[B_+6], P[B_+7]);                                             \
        auto r0 = __builtin_amdgcn_permlane32_swap(a0, b0, false, false); auto r1 = __builtin_amdgcn_permlane32_swap(a1, b1, false, false); \
        u32x4 w = {r0[0], r1[0], r0[1], r1[1]}; OUT = *reinterpret_cast<bf16x8*>(&w); } while (0)
    PK4(p0, 0, pa0); PK4(p0, 8, pa1); PK4(p1, 0, pa2); PK4(p1, 8, pa3);
#undef PK4
}
template <int KB>
__device__ __forceinline__ void qkt(f32x16& p0, f32x16& p1, const char* K_lds, int r32, int hi, const bf16x8* qr) {
    p0 = f32x16{}; p1 = f32x16{};
    const char* kb[4];
#pragma unroll
    for (int dd = 0; dd < 4; ++dd) kb[dd] = K_lds + KB * SHM_K + KSWZ(r32, (dd * 16 + hi * 8) * 2);
#pragma unroll
    for (int d0 = 0; d0 < 8; ++d0) { const char* a = kb[d0 & 3] + (d0 >> 2) * 128;
        bf16x8 b0 = *reinterpret_cast<const bf16x8*>(a);
        bf16x8 b1 = *reinterpret_cast<const bf16x8*>(a + 32 * 256);
        p0 = __builtin_amdgcn_mfma_f32_32x32x16_bf16(b0, qr[d0], p0, 0, 0, 0);
        p1 = __builtin_amdgcn_mfma_f32_32x32x16_bf16(b1, qr[d0], p1, 0, 0, 0); }
}
template <int VB>
__device__ __forceinline__ void pv_tile(f32x16* o, int vb0, bf16x8 pa0, bf16x8 pa1, bf16x8 pa2, bf16x8 pa3) {
#define TRRD(dst, off) asm volatile("ds_read_b64_tr_b16 %0, %1 offset:%2" : "=&v"(dst) : "v"(vb0), "i"(off) : "memory")
#define PV_D0(d0) do { s16x4 l0, l1, l2, l3, h0, h1, h2, h3; constexpr int b_ = VB * SHM_V + v_rd_off(d0, 0, 0); \
        TRRD(l0, b_); TRRD(h0, b_ + 2048); TRRD(l1, b_ + 4096); TRRD(h1, b_ + 6144); TRRD(l2, b_ + 8192); TRRD(h2, b_ + 10240); TRRD(l3, b_ + 12288); TRRD(h3, b_ + 14336); \
        asm volatile("s_waitcnt lgkmcnt(0)" ::: "memory"); SBAR();   \
        o[d0] = __builtin_amdgcn_mfma_f32_32x32x16_bf16(pa0, (bf16x8){l0[0], l0[1], l0[2], l0[3], h0[0], h0[1], h0[2], h0[3]}, o[d0], 0, 0, 0);   \
        o[d0] = __builtin_amdgcn_mfma_f32_32x32x16_bf16(pa1, (bf16x8){l1[0], l1[1], l1[2], l1[3], h1[0], h1[1], h1[2], h1[3]}, o[d0], 0, 0, 0);   \
        o[d0] = __builtin_amdgcn_mfma_f32_32x32x16_bf16(pa2, (bf16x8){l2[0], l2[1], l2[2], l2[3], h2[0], h2[1], h2[2], h2[3]}, o[d0], 0, 0, 0);   \
        o[d0] = __builtin_amdgcn_mfma_f32_32x32x16_bf16(pa3, (bf16x8){l3[0], l3[1], l3[2], l3[3], h3[0], h3[1], h3[2], h3[3]}, o[d0], 0, 0, 0); } while (0)
    PV_D0(0); PV_D0(1); PV_D0(2); PV_D0(3);
#undef PV_D0
#undef TRRD
}
struct BlockRef { unsigned qo, kvo; int P0; };
struct Seam { bf16x8 qr[8]; bf16x8 st_v0, st_v1, st_k0, st_k1; };
typedef __amdgpu_buffer_rsrc_t rsrc_t;
constexpr unsigned TB = 8192u * PITCH * 2u;
__device__ __forceinline__ bf16x8 bld8(rsrc_t r, unsigned voff, unsigned soff) { return __builtin_bit_cast(bf16x8, __builtin_amdgcn_raw_buffer_load_b128(r, voff, soff, 0)); }
#define VMW() asm volatile("s_waitcnt vmcnt(0)" ::: "memory")
#define VMWN(n) asm volatile("s_waitcnt vmcnt(%0)" :: "i"(n) : "memory")
#define SLOAD_H(kvo_, k0) do { const unsigned ko_ = TB + (kvo_) + (unsigned)(k0) * (PITCH * 2u), vo_ = ko_ + TB;              \
                         S.st_v0 = bld8(rq, goff0, vo_); S.st_v1 = bld8(rq, goff0, vo_ + 32u * PITCH * 2u); S.st_k0 = bld8(rq, goff0, ko_); S.st_k1 = bld8(rq, goff0, ko_ + 32u * PITCH * 2u); } while (0)
#define SWRITE_HK(bf) do { *(bf16x8*)(K_lds + (bf) * SHM_K + kws) = S.st_k0; *(bf16x8*)(K_lds + (bf) * SHM_K + kws + 32 * 256) = S.st_k1; } while (0)
#define SWRITE_HV(bf) do { *(bf16x8*)(V_lds + (bf) * SHM_V + vst0) = S.st_v0; *(bf16x8*)(V_lds + (bf) * SHM_V + vst1) = S.st_v1; } while (0)
#define SWRITE_H(bf) do { SWRITE_HV(bf); SWRITE_HK(bf); } while (0)
__device__ __forceinline__ void fox_prime(const BlockRef& cur, rsrc_t rq, char* lds, Seam& S) {
    const int tid = threadIdx.x, wid = __builtin_amdgcn_readfirstlane(tid >> 6), lane = tid & 63, r32 = lane & 31, hi = lane >> 5;
    const int sr = tid >> 4, sc = (tid & 15) * 8, kws = KSWZ(sr, sc * 2); char* K_lds = lds + 2 * SHM_V;
    const unsigned goff0 = (unsigned)(sr * PITCH + sc) * 2u, qoff = (unsigned)(r32 * PITCH + hi * 8) * 2u;
    { const unsigned qs_ = cur.qo + (unsigned)(wid * QBLK) * (PITCH * 2u);
#pragma unroll
    for (int d0 = 0; d0 < 8; ++d0) S.qr[d0] = bld8(rq, qoff + d0 * 32, qs_); }
    SLOAD_H(cur.kvo, 0); VMW(); SWRITE_HK(0);
    __syncthreads();
}
__device__ __forceinline__ void fox_block(const BlockRef& cur, const BlockRef& nxt, rsrc_t rq, rsrc_t ro, char* lds, Seam& S) {
    const int tid = threadIdx.x, wid = __builtin_amdgcn_readfirstlane(tid >> 6), lane = tid & 63, r32 = lane & 31, hi = lane >> 5;
    const int NT = (cur.P0 + QB - 1) / KVBLK + 1;
    const int qlo = cur.P0 + wid * QBLK, qm = qlo + r32 - 4 * hi;
    char* V_lds = lds; char* K_lds = lds + 2 * SHM_V;
    float* ws = (float*)(lds + OFF_WS) + wid * 64; float* li_l = ws, * al_l = ws + 32;
    const FLAS char* kb_l = (const FLAS char*)(FLAS char*)(lds + OFF_KB) + hi * 16;
    float m_reg = -1e30f, l_reg = 0; f32x16 o[4] = {};
    const int sr = tid >> 4, sc = (tid & 15) * 8, vst0 = v_st(sr, sc), vst1 = v_st(32 + sr, sc), kws = KSWZ(sr, sc * 2);
    const unsigned goff0 = (unsigned)(sr * PITCH + sc) * 2u, qoff = (unsigned)(r32 * PITCH + hi * 8) * 2u;
    const int vb0 = (int)(uintptr_t)V_lds + v_rd_base(lane);
#define RESC(a) do { if (__any((a) < 1.f)) { if (hi == 0) al_l[r32] = (a); asm volatile("s_waitcnt lgkmcnt(0)" ::: "memory");              \
                     _Pragma("unroll") for (int d_ = 0; d_ < 4; ++d_) _Pragma("unroll") for (int r = 0; r < 16; ++r) o[d_][r] *= al_l[crow(r, hi)]; } } while (0)
#define KBASE(t) ((t) * KVBLK)
#define PSM(P0_, P1_, mnX, alX, t) do { const int kb_ = KBASE(t); partialSM(P0_, P1_, kb_l + kb_ * 4, (kb_ + KVBLK - 1 > qlo), qm - kb_, m_reg, mnX, alX); } while (0)
    constexpr int NQL = 8;
#define SEAM_K0() do { VMWN(NQL); SWRITE_HK(0); SBAR(); } while (0)
    f32x16 pA0, pA1, pB0, pB1; float mnA, mnB, alA, alB; bf16x8 pa0, pa1, pa2, pa3;
    SWRITE_HV(0); SBAR();
    if (NT > 1) { SLOAD_H(cur.kvo, KBASE(1)); }
    SBAR(); qkt<0>(pA0, pA1, K_lds, r32, hi, S.qr);
    PSM(pA0, pA1, mnA, alA, 0);
    if (NT > 1) { VMW(); SWRITE_H(1); }
    __syncthreads();
#define HALF_STEP(PX0, PX1, mnX, alX, PY0, PY1, alY, t, KB, VB, SB) do {                                                      \
        SBAR(); qkt<KB>(PX0, PX1, K_lds, r32, hi, S.qr);                                             \
        finishSM(PY0, PY1, alY, l_reg, pa0, pa1, pa2, pa3); SBAR();                                                           \
        if ((t) + 1 < NT) { SLOAD_H(cur.kvo, KBASE((t) + 1)); SBAR(); }                                               \
        pv_tile<VB>(o, vb0, pa0, pa1, pa2, pa3); PSM(PX0, PX1, mnX, alX, (t));                                        \
        __syncthreads();                                                                                                      \
        if ((t) + 1 < NT) { VMW(); SWRITE_H(SB); }                                                                          \
        RESC(alX); __syncthreads(); } while (0)
    for (int t = 1; t + 1 < NT; t += 2) {
        HALF_STEP(pB0, pB1, mnB, alB, pA0, pA1, alA, t, 1, 0, 0);
        HALF_STEP(pA0, pA1, mnA, alA, pB0, pB1, alB, t + 1, 0, 1, 1);
    }
    const bool even = (NT & 1) == 0;
    if (even) { SBAR(); qkt<1>(pB0, pB1, K_lds, r32, hi, S.qr); SBAR(); }
    SLOAD_H(nxt.kvo, 0); SBAR();
    { const unsigned qs_ = nxt.qo + (unsigned)(wid * QBLK) * (PITCH * 2u);
#pragma unroll
    for (int d0 = 0; d0 < 8; ++d0) S.qr[d0] = bld8(rq, qoff + d0 * 32, qs_); }
    SBAR();
    finishSM(pA0, pA1, alA, l_reg, pa0, pa1, pa2, pa3); SBAR();
    pv_tile<0>(o, vb0, pa0, pa1, pa2, pa3);
    if (even) { PSM(pB0, pB1, mnB, alB, NT - 1); __syncthreads(); RESC(alB);
        finishSM(pB0, pB1, alB, l_reg, pa0, pa1, pa2, pa3); SBAR(); pv_tile<1>(o, vb0, pa0, pa1, pa2, pa3); }
    SBAR(); SEAM_K0();
    if (hi == 0) li_l[r32] = l_reg; asm volatile("s_waitcnt lgkmcnt(0)" ::: "memory");
    float rli[16];
#pragma unroll
    for (int r = 0; r < 16; ++r) rli[r] = __builtin_amdgcn_rcpf(li_l[crow(r, hi)]);
    const unsigned os_ = cur.qo + (unsigned)(wid * QBLK) * (PITCH * 2u), ooff = (unsigned)(4 * hi * PITCH + r32) * 2u;
#pragma unroll
    for (int r = 0; r < 16; ++r) { const unsigned or_ = os_ + (unsigned)((r & 3) + 8 * (r >> 2)) * (PITCH * 2u);
#pragma unroll
        for (int d0 = 0; d0 < 4; ++d0) { const float v = o[d0][r] * rli[r];
            const float vn = __shfl_xor(v, 1);
            if ((r32 & 1) == 0) __builtin_amdgcn_raw_buffer_store_b32(cvtpk(v, vn), ro, ooff + d0 * 64, or_, 0); } }
    __syncthreads();
#undef RESC
#undef KBASE
#undef PSM
#undef SEAM_K0
#undef HALF_STEP
}
#undef VMW
#undef VMWN
#undef SLOAD_H
#undef SWRITE_HK
#undef SWRITE_HV
#undef SWRITE_H
__device__ __forceinline__ BlockRef mkref(int bh, int qb) { BlockRef r; const unsigned row0 = (unsigned)(bh / NHD) * SQ, h = (unsigned)(bh % NHD);
    r.kvo = (row0 * PITCH + h * D) * 2u; r.qo = r.kvo + (unsigned)qb * (QB * PITCH * 2u); r.P0 = qb * QB; return r; }
__device__ __forceinline__ void load_kb(char* lds, const float* kbias, int bh, int tid) {
    const char* src = (const char*)(kbias + (size_t)bh * SQ);
#pragma unroll
    for (int i = 0; i < SQ / 4 / 512; ++i) { const unsigned off = (unsigned)(tid + 512 * i) * 16u; *(f32x4*)(lds + OFF_KB + off) = *(const f32x4*)(src + off); }
}
__device__ __forceinline__ void fox_phase(char* lds, const bf16* QKV, bf16* O, const float* kbias, int vcu, int G) {
    const rsrc_t rq = __builtin_amdgcn_make_buffer_rsrc((void*)QKV, 0, (int)(3u * TB), 0x00020000), ro = __builtin_amdgcn_make_buffer_rsrc((void*)O, 0, (int)TB, 0x00020000);
    constexpr int NQB = SQ / QB, NX = NQB / 2, TOTAL = NX * 32;
    int L = vcu; if (L >= TOTAL) return;
    const int tid = threadIdx.x;
    int bh = L / NX, y = L % NX, pass = 0;
    load_kb(lds, kbias, bh, tid);
    BlockRef cur = mkref(bh, y);
    Seam S;
    fox_prime(cur, rq, lds, S);
    for (;;) {
        const bool more_pass = pass == 0, more_item = L + G < TOTAL, last = !more_pass && !more_item;
        int Ln = L, bhn = bh, yn = y, passn = pass + 1;
        if (!more_pass) { passn = 0; Ln = more_item ? L + G : L; bhn = Ln / NX; yn = Ln % NX; }
        const BlockRef nxt = last ? cur : mkref(bhn, passn ? NQB - 1 - yn : yn);
        fox_block(cur, nxt, rq, ro, lds, S);
        if (last) break;
        if (bhn != bh) { load_kb(lds, kbias, bhn, tid); __syncthreads(); }
        cur = nxt; L = Ln; bh = bhn; y = yn; pass = passn;
    }
}
#undef KSWZ
#undef SBAR
#undef FLAS
}
constexpr int NWAVES = 8;
constexpr int NB = 2, SEQ = 4096, T = NB * SEQ, DM = 2048, NH = 16, HD = 128, FF = 5632, NE = 8, FE = 7168, PD = 256, GCH = 128, GG = 16;
constexpr int NQKV = 3 * DM, WIN_LD = 3 * DM + NH;
constexpr int MOE_ROWS = 18432;
constexpr float LN_EPS = 1e-5f, ALPHA = 1.41421356237309515f;
constexpr float LOG2E = 1.4426950408889634f;
constexpr int N_PHASES = 18;
constexpr float XS_SCALE = 16.f, WGU_SCALE = 32.f, H_SCALE = 8.f, WDN_SCALE = 128.f;
#ifndef MK_N_LAUNCHES
#define MK_N_LAUNCHES 1
#endif

constexpr size_t MiB = 1u << 20;
constexpr size_t WS_CTL = 0, CTL_ZERO_BYTES = 1 * MiB;
constexpr size_t WS_WQKV = 2 * MiB, WS_WO = 26 * MiB, WS_WGU = 34 * MiB, WS_WDN = 78 * MiB, WS_WPG = 100 * MiB, WS_WPP = 116 * MiB, WS_WGMI = 118 * MiB, WS_WSB = 134 * MiB,
                 WS_WGMO = 135 * MiB, WS_WMGU = 143 * MiB, WS_WMDN = 591 * MiB;
constexpr size_t WS_X0B = 815 * MiB, WS_QKV = 847 * MiB, WS_O = 943 * MiB, WS_PRE = 975 * MiB, WS_X1F = 1039 * MiB, WS_X1B = 1103 * MiB, WS_HB = 1135 * MiB, WS_X2F = 1223 * MiB,
                 WS_X2B = 1287 * MiB, WS_PW = 1319 * MiB, WS_X3F = 1383 * MiB, WS_X3B = 1447 * MiB, WS_UV = 1479 * MiB, WS_VSTAT = 1543 * MiB, WS_YB = 1545 * MiB, WS_X4F = 1577 * MiB,
                 WS_X4B = 1641 * MiB, WS_XS = 1673 * MiB, WS_HM = 1745 * MiB, WS_YS = 1997 * MiB, WS_X5F = 2069 * MiB, WS_X5B = 2133 * MiB, WS_PB = 2165 * MiB, WS_LOGF = 2173 * MiB,
                 WS_KBIAS = 2174 * MiB, WS_ROUTE = 2175 * MiB, WS_END = 2176 * MiB;
static_assert(WS_WMGU + (size_t)NE * 2 * FE * DM * 2 == WS_WMDN && WS_WMDN + (size_t)NE * DM * FE * 2 == WS_X0B, "weight map");
static_assert(WS_HM + (size_t)MOE_ROWS * FE * 2 == WS_YS && WS_HB + (size_t)T * FF * 2 == WS_X2F, "activation map");
constexpr size_t RT_E = 0, RT_POS = 65536, RT_G = 131072, RT_LIST = 196608;
constexpr int CW_TMO = 0, CW_CODE = 1, CW_CNT = 64  , CW_BAR = 4096;

constexpr int RING_BYTES = 131072, LDSCTL_OFF = RING_BYTES, MISC_OFF = LDSCTL_OFF + 320, LDS_BYTES = 147456;

#define GAS __attribute__((address_space(1)))
#define LAS __attribute__((address_space(3)))
typedef unsigned short bf16;
typedef unsigned v4u __attribute__((ext_vector_type(4)));
typedef unsigned v2u __attribute__((ext_vector_type(2)));
typedef float f32x4 __attribute__((ext_vector_type(4)));
typedef float f32x2 __attribute__((ext_vector_type(2)));
typedef short bf16x8 __attribute__((ext_vector_type(8)));
typedef float f32x16 __attribute__((ext_vector_type(16)));
typedef short s16x4 __attribute__((ext_vector_type(4)));
typedef GAS unsigned gu32;
#define RLX_AGENT __ATOMIC_RELAXED, __HIP_MEMORY_SCOPE_AGENT
#define LDS_WAIT() asm volatile("s_waitcnt lgkmcnt(0)" ::: "memory")
#define VM_WAIT() asm volatile("s_waitcnt vmcnt(0)" ::: "memory")
__device__ __forceinline__ unsigned pk2(float lo, float hi) { unsigned r; asm volatile("v_cvt_pk_bf16_f32 %0, %1, %2" : "=v"(r) : "v"(lo), "v"(hi)); return r; }
__device__ __forceinline__ float bflo(unsigned w) { return __uint_as_float(w << 16); }
__device__ __forceinline__ float bfhi(unsigned w) { return __uint_as_float(w & 0xffff0000u); }
__device__ __forceinline__ float wave_sum(float v) {
#pragma unroll
    for (int o = 1; o < 64; o <<= 1) v += __shfl_xor(v, o);
    return v;
}
#define XB_TMO      128
#define XB_XCNT(j)  (256  + 64 * (j))
#define XB_XSUB(j)  (1280 + 64 * (j))
#define XB_XGEN(j)  (2304 + 64 * (j))
#define XB_TOP      3328
#define XB_TOPGEN   3392
#define XCD_BAR_WORDS 3456
#define XB_SPIN_CAP (1u << 18)

__device__ __forceinline__ unsigned xb_ld(unsigned* p)              { return __hip_atomic_load(p, __ATOMIC_RELAXED, __HIP_MEMORY_SCOPE_AGENT); }
__device__ __forceinline__ unsigned xb_add(unsigned* p, unsigned v) { return __hip_atomic_fetch_add(p, v, __ATOMIC_RELAXED, __HIP_MEMORY_SCOPE_AGENT); }
__device__ __forceinline__ unsigned xb_xcc_id() { return (unsigned)__builtin_amdgcn_s_getreg((3 << 11) | 20) & 0xFu; }
#define XB_SPIN(cond, bar) do { unsigned _sp = 0; while (cond) { __builtin_amdgcn_s_sleep(1); \
    if ((++_sp & 255u) == 0u) { if (xb_ld(&(bar)[XB_TMO])) break; if (_sp > XB_SPIN_CAP) { atomicAdd(&(bar)[XB_TMO], 1u); break; } } } } while (0)

struct XcdBarrier {
    unsigned* bar; unsigned x;
    volatile LAS unsigned* st;
};

__device__ __forceinline__ XcdBarrier xcd_barrier_post(unsigned* bar, volatile LAS unsigned* st) {
    XcdBarrier b; b.bar = bar; b.x = xb_xcc_id(); b.st = st;
    if (threadIdx.x == 0) (void)xb_add(&bar[XB_XCNT(b.x)], 1u);
    return b;
}
__device__ __forceinline__ void xcd_barrier_complete(unsigned* bar, unsigned x, unsigned& nloc, unsigned& nx) {
    const unsigned G = gridDim.x * gridDim.y * gridDim.z;
    unsigned sum, cnt, mine, sp = 0u;
    for (;;) {
        sum = 0u; cnt = 0u; mine = 0u;
#pragma unroll
        for (unsigned j = 0; j < 16; ++j) { const unsigned c = xb_ld(&bar[XB_XCNT(j)]); sum += c; cnt += (c > 0u) ? 1u : 0u; mine = (j == x) ? c : mine; }
        if (sum == G) break;
        __builtin_amdgcn_s_sleep(1);
        if ((++sp & 255u) == 0u) { if (xb_ld(&bar[XB_TMO])) break; if (sp > XB_SPIN_CAP) { atomicAdd(&bar[XB_TMO], 1u); break; } }
    }
    nloc = mine > 0u ? mine : 1u; nx = cnt > 0u ? cnt : 1u;
}

__device__ __forceinline__ void xcd_barrier(const XcdBarrier& b) {
    asm volatile("s_waitcnt vmcnt(0)" ::: "memory");
    __syncthreads();
    if (threadIdx.x == 0) {
        unsigned* bar = b.bar;
        __builtin_amdgcn_s_waitcnt(0);
        unsigned nloc = b.st[0], nx = b.st[1];
        if (nloc == 0u) { xcd_barrier_complete(bar, b.x, nloc, nx); b.st[0] = nloc; b.st[1] = nx; }
        const unsigned old = xb_add(&bar[XB_XSUB(b.x)], 1u);
        const unsigned gen = old / nloc;
        if (old + 1u == (gen + 1u) * nloc) {
            __builtin_amdgcn_fence(__ATOMIC_RELEASE, "agent");
            asm volatile("s_waitcnt vmcnt(0)" ::: "memory");
            const unsigned og = xb_add(&bar[XB_TOP], 1u);
            const unsigned tg = og / nx;
            if (og + 1u == (tg + 1u) * nx) xb_add(&bar[XB_TOPGEN], 1u);
            else XB_SPIN(xb_ld(&bar[XB_TOPGEN]) == tg, bar);
            __builtin_amdgcn_fence(__ATOMIC_ACQUIRE, "agent");
            xb_add(&bar[XB_XGEN(b.x)], 1u);
            asm volatile("s_waitcnt vmcnt(0)" ::: "memory");
        } else {
            XB_SPIN(xb_ld(&bar[XB_XGEN(b.x)]) == gen, bar);
            __builtin_amdgcn_fence(__ATOMIC_ACQUIRE, "agent");
            asm volatile("s_waitcnt vmcnt(0)" ::: "memory");
        }
    }
    __syncthreads();
}
__device__ __forceinline__ void transpose_item(const float* W, int ldw, int k0, int n0, bf16* WT, int K, int dr0, LAS float* scr, int lane) {
#pragma unroll 8
    for (int i = 0; i < 32; ++i) { const int kk = 2 * i + (lane >> 5); scr[kk * 33 + (lane & 31)] = W[(size_t)(k0 + kk) * ldw + n0 + (lane & 31)]; }
    LDS_WAIT(); asm volatile("" ::: "memory");
    const int c = lane & 7;
#pragma unroll
    for (int j = 0; j < 4; ++j) { const int n = (lane >> 3) + 8 * j; const LAS float* s = scr + (8 * c) * 33 + n;
        v4u o; o.x = pk2(s[0 * 33], s[1 * 33]); o.y = pk2(s[2 * 33], s[3 * 33]); o.z = pk2(s[4 * 33], s[5 * 33]); o.w = pk2(s[6 * 33], s[7 * 33]);
        *(GAS v4u*)(WT + (size_t)(dr0 + n) * K + k0 + 8 * c) = o; }
    LDS_WAIT(); asm volatile("" ::: "memory");
}
__device__ __forceinline__ unsigned pk4f8(float a, float b, float c, float d) {
    a = __builtin_amdgcn_fmed3f(a, -448.f, 448.f); b = __builtin_amdgcn_fmed3f(b, -448.f, 448.f); c = __builtin_amdgcn_fmed3f(c, -448.f, 448.f); d = __builtin_amdgcn_fmed3f(d, -448.f, 448.f);
    int w = __builtin_amdgcn_cvt_pk_fp8_f32(a, b, 0, false); w = __builtin_amdgcn_cvt_pk_fp8_f32(c, d, w, true); return (unsigned)w; }
__device__ __forceinline__ void transpose_item8(const float* W, int ldw, int k0, int n0, unsigned char* WT, int K, int dr0, float scale, LAS float* scr, int lane) {
#pragma unroll 8
    for (int i = 0; i < 32; ++i) { const int kk = 2 * i + (lane >> 5); scr[kk * 33 + (lane & 31)] = W[(size_t)(k0 + kk) * ldw + n0 + (lane & 31)]; }
    LDS_WAIT(); asm volatile("" ::: "memory");
    const int c = lane & 3;
#pragma unroll
    for (int j = 0; j < 2; ++j) { const int n = (lane >> 2) + 16 * j; const LAS float* s = scr + (16 * c) * 33 + n;
        v4u o; o.x = pk4f8(s[0 * 33] * scale, s[1 * 33] * scale, s[2 * 33] * scale, s[3 * 33] * scale); o.y = pk4f8(s[4 * 33] * scale, s[5 * 33] * scale, s[6 * 33] * scale, s[7 * 33] * scale);
        o.z = pk4f8(s[8 * 33] * scale, s[9 * 33] * scale, s[10 * 33] * scale, s[11 * 33] * scale); o.w = pk4f8(s[12 * 33] * scale, s[13 * 33] * scale, s[14 * 33] * scale, s[15 * 33] * scale);
        *(GAS v4u*)(WT + (size_t)(dr0 + n) * K + k0 + 16 * c) = o; }
    LDS_WAIT(); asm volatile("" ::: "memory");
}
__device__ __forceinline__ int gu_row(int n, int F) { const int isu = n >= F ? 1 : 0, j = n - isu * F; return (j >> 7) * 256 + isu * 128 + (j & 127); }
__device__ __forceinline__ float log_sigmoid(float z) { return fminf(z, 0.f) - log1pf(expf(-fabsf(z))); }

__device__ __forceinline__ const void* karg_ptr(int i) {
    const __attribute__((address_space(4))) char* ka = (const __attribute__((address_space(4))) char*)__builtin_amdgcn_kernarg_segment_ptr();
    return *(const void* const __attribute__((address_space(4)))*)(ka + 8 * i);
}
#define KIN(i) ((const float*)karg_ptr(i))
__device__ __forceinline__ void p0_prologue(unsigned char* ws, LAS unsigned char* lds, int tid, int lane, int wave, int vcu, int G) {
    const int gw = vcu * NWAVES + wave, NGW = G * NWAVES;
    LAS float* wf = (LAS float*)lds;
    for (int i = tid; i < DM * 4; i += NWAVES * 64) { const int k = i >> 2, hq = i & 3; const f32x4 w = *(const f32x4*)(KIN(2) + (size_t)k * WIN_LD + NQKV + hq * 4);
        wf[(hq * 4 + 0) * DM + k] = w[0]; wf[(hq * 4 + 1) * DM + k] = w[1]; wf[(hq * 4 + 2) * DM + k] = w[2]; wf[(hq * 4 + 3) * DM + k] = w[3]; }
    __syncthreads();
    bf16* xb = (bf16*)(ws + WS_X0B); float* logf_o = (float*)(ws + WS_LOGF);
    for (int tb = gw; tb < T / 4; tb += NGW) {
        float acc[4][16];
#pragma unroll
        for (int a = 0; a < 4; ++a)
#pragma unroll
            for (int h = 0; h < 16; ++h) acc[a][h] = 0.f;
#pragma unroll 1
        for (int j = 0; j < 8; ++j) {
            f32x4 xv[4];
#pragma unroll
            for (int a = 0; a < 4; ++a) { xv[a] = *(const f32x4*)(KIN(0) + (size_t)(4 * tb + a) * DM + 256 * j + 4 * lane);
                v2u o; o.x = pk2(xv[a][0], xv[a][1]); o.y = pk2(xv[a][2], xv[a][3]); *(v2u*)(xb + (size_t)(4 * tb + a) * DM + 256 * j + 4 * lane) = o; }
#pragma unroll
            for (int h = 0; h < 16; ++h) { const f32x4 w = *(const LAS f32x4*)(wf + h * DM + 256 * j + 4 * lane);
#pragma unroll
                for (int a = 0; a < 4; ++a) acc[a][h] += (xv[a][0] * w[0] + xv[a][1] * w[1]) + (xv[a][2] * w[2] + xv[a][3] * w[3]); }
        }
        float mine = 0.f;
#pragma unroll
        for (int a = 0; a < 4; ++a)
#pragma unroll
            for (int h = 0; h < 16; ++h) { const float s = wave_sum(acc[a][h]); mine = (lane == a * 16 + h) ? s : mine; }
        logf_o[(size_t)(4 * tb) * 16 + lane] = log_sigmoid(mine + KIN(3)[lane & 15]);
    }
    __syncthreads();
    LAS float* scr = (LAS float*)(lds + wave * 8448);
    constexpr int I_QKV = (DM / 64) * (NQKV / 32), I_SQ = (DM / 64) * (DM / 32), I_GU = (DM / 64) * (2 * FF / 32), I_DN = (FF / 64) * (DM / 32), I_PP = (PD / 64) * (DM / 32),
                  I_GMI = (DM / 64) * (2 * DM / 32), I_MGU = (DM / 64) * (2 * FE / 32), I_MDN = (FE / 64) * (DM / 32);
    constexpr int NITEMS = I_QKV + I_SQ + I_GU + I_DN + 2 * I_SQ + 2 * I_PP + I_GMI + I_SQ + NE * I_MGU + NE * I_MDN;
    for (int it = gw; it < NITEMS; it += NGW) {
        int r = it;
        if (r < I_QKV) { const int nb = NQKV / 32, kb = r / nb, n0 = (r % nb) * 32; transpose_item(KIN(2), WIN_LD, kb * 64, n0, (bf16*)(ws + WS_WQKV), DM, n0, scr, lane); continue; } r -= I_QKV;
        if (r < I_SQ) { const int nb = DM / 32, kb = r / nb, n0 = (r % nb) * 32; transpose_item(KIN(4), DM, kb * 64, n0, (bf16*)(ws + WS_WO), DM, n0, scr, lane); continue; } r -= I_SQ;
        if (r < I_GU) { const int nb = 2 * FF / 32, kb = r / nb, n0 = (r % nb) * 32; transpose_item(KIN(11), 2 * FF, kb * 64, n0, (bf16*)(ws + WS_WGU), DM, gu_row(n0, FF), scr, lane); continue; } r -= I_GU;
        if (r < I_DN) { const int nb = DM / 32, kb = r / nb, n0 = (r % nb) * 32; transpose_item(KIN(12), DM, kb * 64, n0, (bf16*)(ws + WS_WDN), FF, n0, scr, lane); continue; } r -= I_DN;
        if (r < 2 * I_SQ) { const int l = r / I_SQ, q = r % I_SQ, nb = DM / 32, kb = q / nb, n0 = (q % nb) * 32;
            transpose_item(KIN(21) + (size_t)l * DM * DM, DM, kb * 64, n0, (bf16*)(ws + WS_WPG) + (size_t)l * DM * DM, DM, n0, scr, lane); continue; } r -= 2 * I_SQ;
        if (r < 2 * I_PP) { const int l = r / I_PP, q = r % I_PP, nb = DM / 32, kb = q / nb, n0 = (q % nb) * 32;
            transpose_item(KIN(20) + (size_t)l * PD * DM, DM, kb * 64, n0, (bf16*)(ws + WS_WPP) + (size_t)l * DM * PD, PD, n0, scr, lane); continue; } r -= 2 * I_PP;
        if (r < I_GMI) { const int nb = 2 * DM / 32, kb = r / nb, n0 = (r % nb) * 32; transpose_item(KIN(5), 2 * DM, kb * 64, n0, (bf16*)(ws + WS_WGMI), DM, n0, scr, lane); continue; } r -= I_GMI;
        if (r < I_SQ) { const int nb = DM / 32, kb = r / nb, n0 = (r % nb) * 32; transpose_item(KIN(10), DM, kb * 64, n0, (bf16*)(ws + WS_WGMO), DM, n0, scr, lane); continue; } r -= I_SQ;
        if (r < NE * I_MGU) { const int e = r / I_MGU, q = r % I_MGU, nkb = DM / 64, kb = q % nkb, n0 = (q / nkb) * 32;
            transpose_item8(KIN(14) + (size_t)e * DM * 2 * FE, 2 * FE, kb * 64, n0, ws + WS_WMGU + (size_t)e * 2 * FE * DM, DM, gu_row(n0, FE), WGU_SCALE, scr, lane); continue; } r -= NE * I_MGU;
        { const int e = r / I_MDN, q = r % I_MDN, nkb = FE / 64, kb = q % nkb, n0 = (q / nkb) * 32;
            transpose_item8(KIN(15) + (size_t)e * FE * DM, DM, kb * 64, n0, ws + WS_WMDN + (size_t)e * DM * FE, FE, n0, WDN_SCALE, scr, lane); }
    }
    const int gt = vcu * (NWAVES * 64) + tid, NGT = G * NWAVES * 64;
    { bf16* pb = (bf16*)(ws + WS_PB);
      for (int i = gt; i < 2 * T * PD / 8; i += NGT) { const f32x4 a = *(const f32x4*)(KIN(1) + (size_t)i * 8), b = *(const f32x4*)(KIN(1) + (size_t)i * 8 + 4);
          v4u o; o.x = pk2(a[0], a[1]); o.y = pk2(a[2], a[3]); o.z = pk2(b[0], b[1]); o.w = pk2(b[2], b[3]); *(v4u*)(pb + (size_t)i * 8) = o; } }
    { bf16* wsb = (bf16*)(ws + WS_WSB);
      for (int i = gt; i < GG * GCH * GCH / 8; i += NGT) { const int s0 = (i * 8) & (GCH - 1), t = ((i * 8) >> 7) & (GCH - 1);
          const f32x4 a = *(const f32x4*)(KIN(8) + (size_t)i * 8), b = *(const f32x4*)(KIN(8) + (size_t)i * 8 + 4);
          float v[8] = {a[0], a[1], a[2], a[3], b[0], b[1], b[2], b[3]};
#pragma unroll
          for (int e = 0; e < 8; ++e) v[e] = (s0 + e <= t) ? v[e] : 0.f;
          v4u o; o.x = pk2(v[0], v[1]); o.y = pk2(v[2], v[3]); o.z = pk2(v[4], v[5]); o.w = pk2(v[6], v[7]); *(v4u*)(wsb + (size_t)i * 8) = o; } }
}
__device__ __forceinline__ void cumsum_seq(const float* logf_i, float* kbias, int s, LAS unsigned char* lds, int tid, int lane, int wave) {
    const int b = s >> 4, h = s & 15; double v[8]; double run = 0.0;
#pragma unroll
    for (int e = 0; e < 8; ++e) { run += (double)logf_i[((size_t)b * SEQ + tid * 8 + e) * 16 + h]; v[e] = run; }
    double inc = run;
#pragma unroll
    for (int o = 1; o < 64; o <<= 1) { const double u = __shfl_up(inc, o); if (lane >= o) inc += u; }
    LAS double* wt = (LAS double*)lds;
    if (lane == 63) wt[wave] = inc;
    __syncthreads();
    double base = inc - run;
    for (int w = 0; w < wave; ++w) base += wt[w];
#pragma unroll
    for (int e = 0; e < 8; ++e) kbias[(size_t)s * SEQ + tid * 8 + e] = (float)(-(base + v[e]) * 1.4426950408889634);
    __syncthreads();
}
__device__ __forceinline__ void ln_row(f32x4 (&v)[8], const float* g, const float* b, int lane) {
    float s = 0.f;
#pragma unroll
    for (int j = 0; j < 8; ++j) s += (v[j][0] + v[j][1]) + (v[j][2] + v[j][3]);
    const float mean = wave_sum(s) * (1.f / DM); float s2 = 0.f;
#pragma unroll
    for (int j = 0; j < 8; ++j) { v[j] = v[j] - mean; s2 += (v[j][0] * v[j][0] + v[j][1] * v[j][1]) + (v[j][2] * v[j][2] + v[j][3] * v[j][3]); }
    const float rstd = 1.0f / sqrtf(wave_sum(s2) * (1.f / DM) + LN_EPS);
#pragma unroll
    for (int j = 0; j < 8; ++j) { const f32x4 gv = *(const f32x4*)(g + 256 * j + 4 * lane), bv = *(const f32x4*)(b + 256 * j + 4 * lane); v[j] = v[j] * rstd * gv + bv; }
}
__device__ __forceinline__ void store_row(const f32x4 (&v)[8], float* of, bf16* ob, int lane) {
#pragma unroll
    for (int j = 0; j < 8; ++j) { *(f32x4*)(of + 256 * j + 4 * lane) = v[j]; v2u o; o.x = pk2(v[j][0], v[j][1]); o.y = pk2(v[j][2], v[j][3]); *(v2u*)(ob + 256 * j + 4 * lane) = o; }
}
__device__ __forceinline__ void ln_phase(const float* pre, const float* g, const float* b, float* of, bf16* ob, int lane, int gw, int NGW) {
    for (int m = gw; m < T; m += NGW) { f32x4 v[8];
#pragma unroll
        for (int j = 0; j < 8; ++j) v[j] = *(const f32x4*)(pre + (size_t)m * DM + 256 * j + 4 * lane);
        ln_row(v, g, b, lane); store_row(v, of + (size_t)m * DM, ob + (size_t)m * DM, lane); }
}
__device__ __forceinline__ void ln_router_phase(const float* pre, const float* g, const float* b, float* of, bf16* ob, const float* w_router, unsigned char* route, gu32* ctl,
                                                LAS unsigned char* lds, int tid, int lane, int gw, int NGW) {
    LAS float* wr = (LAS float*)lds;
    for (int i = tid; i < DM * 2; i += NWAVES * 64) { const int k = i >> 1, eq = i & 1; const f32x4 w = *(const f32x4*)(w_router + (size_t)k * NE + eq * 4);
        wr[(eq * 4 + 0) * DM + k] = w[0]; wr[(eq * 4 + 1) * DM + k] = w[1]; wr[(eq * 4 + 2) * DM + k] = w[2]; wr[(eq * 4 + 3) * DM + k] = w[3]; }
    __syncthreads();
    int* tok_e = (int*)(route + RT_E); int* tok_pos = (int*)(route + RT_POS); float* tok_g = (float*)(route + RT_G); int* elist = (int*)(route + RT_LIST);
    for (int m = gw; m < T; m += NGW) { f32x4 v[8];
#pragma unroll
        for (int j = 0; j < 8; ++j) v[j] = *(const f32x4*)(pre + (size_t)m * DM + 256 * j + 4 * lane);
        ln_row(v, g, b, lane); store_row(v, of + (size_t)m * DM, ob + (size_t)m * DM, lane);
        float lg[8];
#pragma unroll
        for (int e = 0; e < 8; ++e) { float a = 0.f;
#pragma unroll
            for (int j = 0; j < 8; ++j) { const f32x4 w = *(const LAS f32x4*)(wr + e * DM + 256 * j + 4 * lane); a += (v[j][0] * w[0] + v[j][1] * w[1]) + (v[j][2] * w[2] + v[j][3] * w[3]); }
            lg[e] = wave_sum(a); }
        int i1 = 0; float v1 = lg[0];
#pragma unroll
        for (int e = 1; e < 8; ++e) if (lg[e] > v1) { v1 = lg[e]; i1 = e; }
        int i2 = -1; float v2 = -__builtin_inff();
#pragma unroll
        for (int e = 0; e < 8; ++e) if (e != i1 && lg[e] > v2) { v2 = lg[e]; i2 = e; }
        const float ex = expf(v2 - v1), g1 = 1.0f / (1.0f + ex), g2 = ex / (1.0f + ex);
        if (lane == 0) { const int p1 = (int)__hip_atomic_fetch_add(ctl + CW_CNT + 64 * i1, 1u, RLX_AGENT), p2 = (int)__hip_atomic_fetch_add(ctl + CW_CNT + 64 * i2, 1u, RLX_AGENT);
            tok_e[2 * m] = i1; tok_e[2 * m + 1] = i2; tok_pos[2 * m] = p1; tok_pos[2 * m + 1] = p2; tok_g[2 * m] = g1; tok_g[2 * m + 1] = g2;
            elist[i1 * T + p1] = m; elist[i2 * T + p2] = m; }
    }
    __syncthreads();
}
__device__ __forceinline__ void moe_tiles(const gu32* ctl, int (&ts)[9], int (&cnt)[8]) {
    ts[0] = 0;
#pragma unroll
    for (int e = 0; e < 8; ++e) { cnt[e] = __builtin_amdgcn_readfirstlane((int)__hip_atomic_load(ctl + CW_CNT + 64 * e, RLX_AGENT)); ts[e + 1] = ts[e] + ((cnt[e] + 255) >> 8); }
}
__device__ __forceinline__ void moe_permute_phase(const float* x4, unsigned char* xs, const unsigned char* route, const gu32* ctl, int lane, int gw, int NGW) {
    int ts[9], cnt[8]; moe_tiles(ctl, ts, cnt);
    const int* elist = (const int*)(route + RT_LIST);
    for (int r = gw; r < ts[8] * 256; r += NGW) { const int mt = r >> 8; int e = 0, t0 = 0, c = cnt[0];
#pragma unroll
        for (int j = 1; j < 8; ++j) if (mt >= ts[j]) { e = j; t0 = ts[j]; c = cnt[j]; }
        const int pos = r - t0 * 256; v2u a[4];
        if (pos < c) { const int tok = elist[e * T + pos];
#pragma unroll
            for (int j = 0; j < 4; ++j) { const f32x4 u0 = *(const f32x4*)(x4 + (size_t)tok * DM + 512 * j + 8 * lane) * XS_SCALE, u1 = *(const f32x4*)(x4 + (size_t)tok * DM + 512 * j + 8 * lane + 4) * XS_SCALE;
                a[j].x = pk4f8(u0[0], u0[1], u0[2], u0[3]); a[j].y = pk4f8(u1[0], u1[1], u1[2], u1[3]); } }
        else {
#pragma unroll
            for (int j = 0; j < 4; ++j) a[j] = (v2u){0u, 0u}; }
#pragma unroll
        for (int j = 0; j < 4; ++j) *(v2u*)(xs + (size_t)r * DM + 512 * j + 8 * lane) = a[j]; }
}
__device__ __forceinline__ void ln_moe_phase(const float* x4, const bf16* ys, const float* g, const float* b, float* of, bf16* ob, const unsigned char* route, const gu32* ctl, int lane, int gw, int NGW) {
    int ts[9], cnt[8]; moe_tiles(ctl, ts, cnt);
    const int* tok_e = (const int*)(route + RT_E); const int* tok_pos = (const int*)(route + RT_POS); const float* tok_g = (const float*)(route + RT_G);
    for (int m = gw; m < T; m += NGW) {
        const int e1 = __builtin_amdgcn_readfirstlane(tok_e[2 * m]), e2 = __builtin_amdgcn_readfirstlane(tok_e[2 * m + 1]);
        const int p1 = __builtin_amdgcn_readfirstlane(tok_pos[2 * m]), p2 = __builtin_amdgcn_readfirstlane(tok_pos[2 * m + 1]);
        const float g1 = tok_g[2 * m], g2 = tok_g[2 * m + 1];
        int t1 = 0, t2 = 0;
#pragma unroll
        for (int j = 0; j < 8; ++j) { t1 = (e1 == j) ? ts[j] : t1; t2 = (e2 == j) ? ts[j] : t2; }
        const bf16* y1 = ys + (size_t)(t1 * 256 + p1) * DM; const bf16* y2 = ys + (size_t)(t2 * 256 + p2) * DM;
        f32x4 v[8];
#pragma unroll
        for (int j = 0; j < 8; ++j) { const f32x4 xv = *(const f32x4*)(x4 + (size_t)m * DM + 256 * j + 4 * lane); const v2u a = *(const v2u*)(y1 + 256 * j + 4 * lane), c = *(const v2u*)(y2 + 256 * j + 4 * lane);
            f32x4 o; o[0] = ALPHA * xv[0] + (g1 * bflo(a.x) + g2 * bflo(c.x)); o[1] = ALPHA * xv[1] + (g1 * bfhi(a.x) + g2 * bfhi(c.x));
            o[2] = ALPHA * xv[2] + (g1 * bflo(a.y) + g2 * bflo(c.y)); o[3] = ALPHA * xv[3] + (g1 * bfhi(a.y) + g2 * bfhi(c.y)); v[j] = o; }
        ln_row(v, g, b, lane); store_row(v, of + (size_t)m * DM, ob + (size_t)m * DM, lane); }
}
__device__ __forceinline__ void gating_unit(int uid, const bf16* uv, const float* vstat, const bf16* wsb, const float* lng, const float* lnb, const float* bs, bf16* yb,
                                            LAS unsigned char* lds, int tid, int lane, int wave) {
    const int bc = uid >> 4, g = uid & 15, tok0 = bc * GCH;
    LAS float* st = (LAS float*)(lds + 32768);
    if (tid < GCH) { const f32x4* sp = (const f32x4*)(vstat + (size_t)(tok0 + tid) * 64); float s = 0.f, q = 0.f;
#pragma unroll
        for (int i = 0; i < 16; ++i) { const f32x4 a = sp[i]; s += a[0] + a[2]; q += a[1] + a[3]; }
        const float mean = s * (1.f / DM), var = fmaxf(q * (1.f / DM) - mean * mean, 0.f);
        st[2 * tid] = mean; st[2 * tid + 1] = 1.0f / sqrtf(var + LN_EPS); }
    __syncthreads();
    { const int sr = tid >> 4, sc = (tid & 15) * 8;
      const f32x4 g0 = *(const f32x4*)(lng + g * GCH + sc), g1 = *(const f32x4*)(lng + g * GCH + sc + 4), b0 = *(const f32x4*)(lnb + g * GCH + sc), b1 = *(const f32x4*)(lnb + g * GCH + sc + 4);
#pragma unroll
      for (int q = 0; q < 4; ++q) { const int s = 32 * q + sr; const v4u raw = *(const v4u*)(uv + (size_t)(tok0 + s) * (2 * DM) + DM + g * GCH + sc);
          const float mean = st[2 * s], rstd = st[2 * s + 1];
          float f[8] = {bflo(raw.x), bfhi(raw.x), bflo(raw.y), bfhi(raw.y), bflo(raw.z), bfhi(raw.z), bflo(raw.w), bfhi(raw.w)};
#pragma unroll
          for (int e = 0; e < 4; ++e) { f[e] = (f[e] - mean) * rstd * g0[e] + b0[e]; f[4 + e] = (f[4 + e] - mean) * rstd * g1[e] + b1[e]; }
          v4u o; o.x = pk2(f[0], f[1]); o.y = pk2(f[2], f[3]); o.z = pk2(f[4], f[5]); o.w = pk2(f[6], f[7]);
          *(LAS v4u*)(lds + (s >> 6) * fox::SHM_V + fox::v_st(s & 63, sc)) = o; } }
    __syncthreads();
    const int r32 = lane & 31, hi = lane >> 5, ib = wave >> 1, dh = wave & 1;
    bf16x8 pa[8];
#pragma unroll
    for (int ks = 0; ks < 8; ++ks) pa[ks] = *(const bf16x8*)(wsb + ((size_t)(g * GCH + 32 * ib + r32)) * GCH + 16 * ks + 8 * hi);
    const int vb0 = (int)(uintptr_t)lds + fox::v_rd_base(lane) + dh * 1024;
    f32x16 o[2] = {};
#define G_TRRD(dst, off) asm volatile("ds_read_b64_tr_b16 %0, %1 offset:%2" : "=&v"(dst) : "v"(vb0), "i"(off) : "memory")
#define G_D0(ti, dd) do { s16x4 l0, l1, l2, l3, h0, h1, h2, h3; \
        G_TRRD(l0, (ti) * 16384 + (dd) * 512); G_TRRD(h0, (ti) * 16384 + (dd) * 512 + 2048); G_TRRD(l1, (ti) * 16384 + (dd) * 512 + 4096); G_TRRD(h1, (ti) * 16384 + (dd) * 512 + 6144); \
        G_TRRD(l2, (ti) * 16384 + (dd) * 512 + 8192); G_TRRD(h2, (ti) * 16384 + (dd) * 512 + 10240); G_TRRD(l3, (ti) * 16384 + (dd) * 512 + 12288); G_TRRD(h3, (ti) * 16384 + (dd) * 512 + 14336); \
        asm volatile("s_waitcnt lgkmcnt(0)" ::: "memory"); __builtin_amdgcn_sched_barrier(0); \
        o[dd] = __builtin_amdgcn_mfma_f32_32x32x16_bf16(pa[4 * (ti) + 0], (bf16x8){l0[0], l0[1], l0[2], l0[3], h0[0], h0[1], h0[2], h0[3]}, o[dd], 0, 0, 0); \
        o[dd] = __builtin_amdgcn_mfma_f32_32x32x16_bf16(pa[4 * (ti) + 1], (bf16x8){l1[0], l1[1], l1[2], l1[3], h1[0], h1[1], h1[2], h1[3]}, o[dd], 0, 0, 0); \
        o[dd] = __builtin_amdgcn_mfma_f32_32x32x16_bf16(pa[4 * (ti) + 2], (bf16x8){l2[0], l2[1], l2[2], l2[3], h2[0], h2[1], h2[2], h2[3]}, o[dd], 0, 0, 0); \
        o[dd] = __builtin_amdgcn_mfma_f32_32x32x16_bf16(pa[4 * (ti) + 3], (bf16x8){l3[0], l3[1], l3[2], l3[3], h3[0], h3[1], h3[2], h3[3]}, o[dd], 0, 0, 0); } while (0)
    G_D0(0, 0); G_D0(0, 1); G_D0(1, 0); G_D0(1, 1);
#undef G_D0
#undef G_TRRD
#pragma unroll
    for (int r = 0; r < 16; ++r) { const int t = 32 * ib + fox::crow(r, hi); const float bsv = bs[g * GCH + t];
#pragma unroll
        for (int dd = 0; dd < 2; ++dd) { const int col = g * GCH + (2 * dh + dd) * 32 + r32;
            const float uval = __uint_as_float((unsigned)uv[(size_t)(tok0 + t) * (2 * DM) + col] << 16);
            const float v = uval * (o[dd][r] + bsv), vn = __shfl_xor(v, 1);
            if ((r32 & 1) == 0) *(unsigned*)(yb + (size_t)(tok0 + t) * DM + col) = pk2(v, vn); } }
    __syncthreads();
}
struct Args { const void* in[22]; float* out; unsigned char* ws; int ph_lo, ph_hi; };
__global__ void __launch_bounds__(NWAVES * 64, 2) fwd(Args args) {
    extern __shared__ __attribute__((aligned(16))) unsigned char lds_raw[];
    LAS unsigned char* lds = (LAS unsigned char*)lds_raw;
    volatile LAS unsigned* MISC = (volatile LAS unsigned*)(lds + MISC_OFF);
    const int tid = threadIdx.x, lane = tid & 63, wave = __builtin_amdgcn_readfirstlane(tid >> 6);
    const int G = gridDim.x, bx = blockIdx.x, vcu = (G % 8 == 0) ? (bx % 8) * (G / 8) + bx / 8 : bx;
    const int gw = vcu * NWAVES + wave, NGW = G * NWAVES;
    unsigned char* ws = (unsigned char*)karg_ptr(23); gu32* ctl = (gu32*)(ws + WS_CTL);
#define x_in ((const float*)karg_ptr(0))
#define p_in ((const float*)karg_ptr(1))
#define fox_w_in ((const float*)karg_ptr(2))
#define fox_b_f ((const float*)karg_ptr(3))
#define fox_w_o ((const float*)karg_ptr(4))
#define gm_w_in ((const float*)karg_ptr(5))
#define gm_ln_v_g ((const float*)karg_ptr(6))
#define gm_ln_v_b ((const float*)karg_ptr(7))
#define gm_w_s ((const float*)karg_ptr(8))
#define gm_b_s ((const float*)karg_ptr(9))
#define gm_w_o ((const float*)karg_ptr(10))
#define ffn_w_gu ((const float*)karg_ptr(11))
#define ffn_w_down ((const float*)karg_ptr(12))
#define moe_w_router ((const float*)karg_ptr(13))
#define moe_w_gu ((const float*)karg_ptr(14))
#define moe_w_down ((const float*)karg_ptr(15))
#define ln_mix_g ((const float*)karg_ptr(16))
#define ln_mix_b ((const float*)karg_ptr(17))
#define ln_ch_g ((const float*)karg_ptr(18))
#define ln_ch_b ((const float*)karg_ptr(19))
#define ple_w_proj ((const float*)karg_ptr(20))
#define ple_w_gate ((const float*)karg_ptr(21))
#define Wqkv ((bf16*)(ws + WS_WQKV))
#define Wo ((bf16*)(ws + WS_WO))
#define Wgu ((bf16*)(ws + WS_WGU))
#define Wdn ((bf16*)(ws + WS_WDN))
#define Wpg ((bf16*)(ws + WS_WPG))
#define Wpp ((bf16*)(ws + WS_WPP))
#define Wgmi ((bf16*)(ws + WS_WGMI))
#define Wsb ((bf16*)(ws + WS_WSB))
#define Wgmo ((bf16*)(ws + WS_WGMO))
#define Wmgu ((bf16*)(ws + WS_WMGU))
#define Wmdn ((bf16*)(ws + WS_WMDN))
#define X0B ((bf16*)(ws + WS_X0B))
#define QKV ((bf16*)(ws + WS_QKV))
#define OB ((bf16*)(ws + WS_O))
#define X1B ((bf16*)(ws + WS_X1B))
#define HB ((bf16*)(ws + WS_HB))
#define X2B ((bf16*)(ws + WS_X2B))
#define PW ((bf16*)(ws + WS_PW))
#define X3B ((bf16*)(ws + WS_X3B))
#define UV ((bf16*)(ws + WS_UV))
#define YB ((bf16*)(ws + WS_YB))
#define X4B ((bf16*)(ws + WS_X4B))
#define XS ((bf16*)(ws + WS_XS))
#define HM ((bf16*)(ws + WS_HM))
#define YS ((bf16*)(ws + WS_YS))
#define X5B ((bf16*)(ws + WS_X5B))
#define PB ((bf16*)(ws + WS_PB))
#define PRE ((float*)(ws + WS_PRE))
#define X1F ((float*)(ws + WS_X1F))
#define X2F ((float*)(ws + WS_X2F))
#define X3F ((float*)(ws + WS_X3F))
#define X4F ((float*)(ws + WS_X4F))
#define X5F ((float*)(ws + WS_X5F))
#define VSTAT ((float*)(ws + WS_VSTAT))
#define LOGF ((float*)(ws + WS_LOGF))
#define KBIAS ((float*)(ws + WS_KBIAS))
#define ROUTE (ws + WS_ROUTE)

    for (int u = tid; u < (LDS_BYTES - LDSCTL_OFF) / 4; u += NWAVES * 64) ((LAS unsigned*)(lds + LDSCTL_OFF))[u] = 0u;
    __syncthreads();
    constexpr bool ONE = (MK_N_LAUNCHES == 1);
    XcdBarrier bar; bar.bar = (unsigned*)(ctl + CW_BAR); bar.x = 0; bar.st = nullptr;
    if (ONE) bar = xcd_barrier_post((unsigned*)(ctl + CW_BAR), MISC + 8);
    const int lo = args.ph_lo, hi = args.ph_hi;
#ifndef PH_MASK
#define PH_MASK 0x3ffff
#endif
#define IN(k) (((PH_MASK >> (k)) & 1) && lo <= (k) && (k) < hi)
#define PHASE(k) if (IN(k))
#define SEAM(k) do { if (ONE && IN((k) + 1)) xcd_barrier(bar); } while (0)
#define GEMM_CALL(EPI, ORD, g, S, E) pg8::gemm_phase<EPI, ORD, true, true>((PG8_LAS unsigned char*)lds, g, S, E)

    PHASE(0) {
        p0_prologue(ws, lds, tid, lane, wave, vcu, G);
        SEAM(0);
    }
    PHASE(1) {
        for (int s = vcu; s < NB * NH; s += G) cumsum_seq(LOGF, KBIAS, s, lds, tid, lane, wave);
        __syncthreads();
        { pg8::Gemm g{X0B, Wqkv, T, NQKV, DM}; pg8::StaticOrder S; S.init(T, NQKV, G, bx); pg8::EpiBf16S E{QKV, DM, DM, (size_t)T * DM, 1.f}; GEMM_CALL(pg8::EpiBf16S, pg8::StaticOrder, g, S, E); }
        { pg8::Gemm g{PB, Wpp, T, DM, PD}; pg8::StaticOrder S; S.init(T, DM, G, bx); pg8::EpiBf16S E{PW, DM, 0, 0, 1.f}; GEMM_CALL(pg8::EpiBf16S, pg8::StaticOrder, g, S, E); }
        { pg8::Gemm g{PB + (size_t)T * PD, Wpp + (size_t)DM * PD, T, DM, PD}; pg8::StaticOrder S; S.init(T, DM, G, bx); pg8::EpiBf16S E{PW + (size_t)T * DM, DM, 0, 0, 1.f}; GEMM_CALL(pg8::EpiBf16S, pg8::StaticOrder, g, S, E); }
        SEAM(1);
    }
    PHASE(2) {
        static_assert(fox::LDS_BYTES <= RING_BYTES, "attention LDS");
        fox::fox_phase((char*)lds_raw, (const fox::bf16*)QKV, (fox::bf16*)OB, KBIAS, vcu, G);
        SEAM(2);
    }
    PHASE(3) {
        pg8::Gemm g{OB, Wo, T, DM, DM}; pg8::StaticOrder S; S.init(T, DM, G, bx); pg8::EpiResF32 E{x_in, PRE, DM, ALPHA}; GEMM_CALL(pg8::EpiResF32, pg8::StaticOrder, g, S, E);
        SEAM(3);
    }
    PHASE(4) { ln_phase(PRE, ln_mix_g, ln_mix_b, X1F, X1B, lane, gw, NGW); SEAM(4); }
    PHASE(5) {
        pg8::Gemm g{X1B, Wgu, T, 2 * FF, DM}; pg8::StaticOrder S; S.init(T, 2 * FF, G, bx); pg8::EpiSwiGLU E{HB, FF}; GEMM_CALL(pg8::EpiSwiGLU, pg8::StaticOrder, g, S, E);
        SEAM(5);
    }
    PHASE(6) {
        pg8::Gemm g{HB, Wdn, T, DM, FF}; pg8::StaticOrder S; S.init(T, DM, G, bx); pg8::EpiResF32 E{X1F, PRE, DM, ALPHA}; GEMM_CALL(pg8::EpiResF32, pg8::StaticOrder, g, S, E);
        SEAM(6);
    }
    PHASE(7) { ln_phase(PRE, ln_ch_g, ln_ch_b, X2F, X2B, lane, gw, NGW); SEAM(7); }
    PHASE(8) {
        pg8::Gemm g{X2B, Wpg, T, DM, DM}; pg8::StaticOrder S; S.init(T, DM, G, bx); pg8::EpiPLE E{X2F, PW, X3F, X3B, DM}; GEMM_CALL(pg8::EpiPLE, pg8::StaticOrder, g, S, E);
        SEAM(8);
    }
    PHASE(9) {
        pg8::Gemm g{X3B, Wgmi, T, 2 * DM, DM}; pg8::StaticOrder S; S.init(T, 2 * DM, G, bx); pg8::EpiGeluStats E{UV, 2 * DM, VSTAT, DM / 256}; GEMM_CALL(pg8::EpiGeluStats, pg8::StaticOrder, g, S, E);
        SEAM(9);
    }
    PHASE(10) {
        for (int uid = vcu; uid < (T / GCH) * GG; uid += G) gating_unit(uid, UV, VSTAT, Wsb, gm_ln_v_g, gm_ln_v_b, gm_b_s, YB, lds, tid, lane, wave);
        SEAM(10);
    }
    PHASE(11) {
        pg8::Gemm g{YB, Wgmo, T, DM, DM}; pg8::StaticOrder S; S.init(T, DM, G, bx); pg8::EpiResF32 E{X3F, PRE, DM, ALPHA}; GEMM_CALL(pg8::EpiResF32, pg8::StaticOrder, g, S, E);
        SEAM(11);
    }
    PHASE(12) { ln_router_phase(PRE, ln_mix_g + DM, ln_mix_b + DM, X4F, X4B, moe_w_router, ROUTE, ctl, lds, tid, lane, gw, NGW); SEAM(12); }
    PHASE(13) { moe_permute_phase(X4F, (unsigned char*)XS, ROUTE, ctl, lane, gw, NGW); SEAM(13); }
    PHASE(14) {
        int ts[9], cnt[8]; moe_tiles(ctl, ts, cnt);
        pg8::Gemm g{XS, Wmgu, MOE_ROWS, 2 * FE, DM / 2}; pg8::MoeOrder S; S.init(ts, 2 * FE / 256, G, bx); pg8::EpiSwiGLU8 E{(unsigned char*)HM, FE, 1.f / (XS_SCALE * WGU_SCALE), H_SCALE};
        pg8::gemm_phase<pg8::EpiSwiGLU8, pg8::MoeOrder, true, true, true>((PG8_LAS unsigned char*)lds, g, S, E);
        SEAM(14);
    }
    PHASE(15) {
        int ts[9], cnt[8]; moe_tiles(ctl, ts, cnt);
        pg8::Gemm g{HM, Wmdn, MOE_ROWS, DM, FE / 2}; pg8::MoeOrder S; S.init(ts, DM / 256, G, bx); pg8::EpiBf16S E{YS, DM, 0, 0, 1.f / (H_SCALE * WDN_SCALE)};
        pg8::gemm_phase<pg8::EpiBf16S, pg8::MoeOrder, true, true, true>((PG8_LAS unsigned char*)lds, g, S, E);
        SEAM(15);
    }
    PHASE(16) { ln_moe_phase(X4F, YS, ln_ch_g + DM, ln_ch_b + DM, X5F, X5B, ROUTE, ctl, lane, gw, NGW); SEAM(16); }
    PHASE(17) {
        pg8::Gemm g{X5B, Wpg + (size_t)DM * DM, T, DM, DM}; pg8::StaticOrder S; S.init(T, DM, G, bx); pg8::EpiPLE E{X5F, PW + (size_t)T * DM, (float*)karg_ptr(22), nullptr, DM}; GEMM_CALL(pg8::EpiPLE, pg8::StaticOrder, g, S, E);
    }
#undef IN
#undef SEAM
#undef PHASE
#undef GEMM_CALL
#undef x_in
#undef p_in
#undef fox_w_in
#undef fox_b_f
#undef fox_w_o
#undef gm_w_in
#undef gm_ln_v_g
#undef gm_ln_v_b
#undef gm_w_s
#undef gm_b_s
#undef gm_w_o
#undef ffn_w_gu
#undef ffn_w_down
#undef moe_w_router
#undef moe_w_gu
#undef moe_w_down
#undef ln_mix_g
#undef ln_mix_b
#undef ln_ch_g
#undef ln_ch_b
#undef ple_w_proj
#undef ple_w_gate
#undef Wqkv
#undef Wo
#undef Wgu
#undef Wdn
#undef Wpg
#undef Wpp
#undef Wgmi
#undef Wsb
#undef Wgmo
#undef Wmgu
#undef Wmdn
#undef X0B
#undef QKV
#undef OB
#undef X1B
#undef HB
#undef X2B
#undef PW
#undef X3B
#undef UV
#undef YB
#undef X4B
#undef XS
#undef HM
#undef YS
#undef X5B
#undef PB
#undef PRE
#undef X1F
#undef X2F
#undef X3F
#undef X4F
#undef X5F
#undef VSTAT
#undef LOGF
#undef KBIAS
#undef ROUTE
}

extern "C" void kernel_launch(void* const* d_in, const int* in_sizes, int n_in, void* d_out, int out_size, void* d_ws, size_t ws_size, hipStream_t stream) {
    static int grid = 0;
    if (grid == 0) {
        if (n_in != 22 || in_sizes[0] != T * DM || out_size != T * DM || ws_size < WS_END) {
            fprintf(stderr, "kernel_launch: built for 22 inputs, x/out of %d floats, >= %zu bytes of workspace; got n_in %d, in0 %d, out %d, ws %zu; nothing launched\n", T * DM, (size_t)WS_END, n_in, n_in > 0 ? in_sizes[0] : -1, out_size, ws_size);
            grid = -1; return; }
        int dev = 0, cus = 0, per_cu = 0;
        if (hipGetDevice(&dev) != hipSuccess || hipDeviceGetAttribute(&cus, hipDeviceAttributeMultiprocessorCount, dev) != hipSuccess) { fprintf(stderr, "kernel_launch: device query failed\n"); grid = -1; return; }
        if (hipFuncSetAttribute((const void*)fwd, hipFuncAttributeMaxDynamicSharedMemorySize, LDS_BYTES) != hipSuccess) { fprintf(stderr, "kernel_launch: hipFuncSetAttribute failed\n"); grid = -1; return; }
        if (hipOccupancyMaxActiveBlocksPerMultiprocessor(&per_cu, (const void*)fwd, NWAVES * 64, LDS_BYTES) != hipSuccess || per_cu < 1)
            fprintf(stderr, "kernel_launch: note: occupancy query reports %d workgroups per CU\n", per_cu);
        (void)hipGetLastError();
        grid = cus;
    }
    if (grid < 0) return;
    if (hipMemsetAsync((char*)d_ws + WS_CTL, 0, CTL_ZERO_BYTES, stream) != hipSuccess) { fprintf(stderr, "kernel_launch: memset failed\n"); return; }
    Args a{};
    for (int i = 0; i < 22; ++i) a.in[i] = d_in[i];
    a.out = (float*)d_out; a.ws = (unsigned char*)d_ws;
    for (int li = 0; li < MK_N_LAUNCHES; ++li) {
        a.ph_lo = (MK_N_LAUNCHES == 1) ? 0 : li; a.ph_hi = (MK_N_LAUNCHES == 1) ? N_PHASES : li + 1;
        hipLaunchKernelGGL(fwd, dim3(grid), dim3(NWAVES * 64), LDS_BYTES, stream, a);
        const hipError_t le = hipPeekAtLastError();
        if (le != hipSuccess) { fprintf(stderr, "kernel_launch: launch %d failed: %s\n", li, hipGetErrorName(le)); break; }
    }
#ifdef PROBE_MASK
    for (int k = 0; k < N_PHASES; ++k) if ((PROBE_MASK >> k) & 1) { a.ph_lo = k; a.ph_hi = k + 1; hipLaunchKernelGGL(fwd, dim3(grid), dim3(NWAVES * 64), LDS_BYTES, stream, a); }
#endif
}
```

```cpp
#define P14_GEMM_16THS 14
#include <hip/hip_runtime.h>
#include <hip/hip_bf16.h>
#include <cstdio>
#include <cstdint>
__device__ __forceinline__ int opaque_tid() { int t; asm volatile("v_mov_b32 %0, %1" : "=v"(t) : "v"((int)threadIdx.x)); return t; }
namespace pg8 {
#define PG8_LAS __attribute__((address_space(3)))
typedef unsigned short bf16_t;
typedef short bf16x8 __attribute__((ext_vector_type(8)));
typedef float f32x4 __attribute__((ext_vector_type(4)));
typedef unsigned u32x4 __attribute__((ext_vector_type(4)));
typedef int i32x4_t __attribute__((ext_vector_type(4)));
typedef int i32x8_t __attribute__((ext_vector_type(8)));
constexpr int BM = 256, BK = 64, HALF = 128, HTB = HALF * BK * 2  , STAGE_BYTES = 8 * HTB, NXCD = 8, WGM = 8;

__host__ __device__ __forceinline__ int lds_byte(int r, int c) { const int st = (r >> 4) * 2 + (c >> 5), rr = r & 15, cc = c & 31, ob = rr * 64 + cc * 2; return st * 1024 + (ob ^ (((ob >> 9) & 1) << 5)); }
__host__ __device__ __forceinline__ void stage_rc(int b, int& R, int& C) { const int st = b / 1024, sb = b % 1024, swz = sb ^ (((sb >> 9) & 1) << 5); R = (st >> 1) * 16 + swz / 64; C = (st & 1) * 32 + (swz % 64) / 2; }
__host__ __device__ __forceinline__ int perm32(int rho) { const int n = rho >> 4, i = rho & 15; return 8 * (i >> 2) + 4 * n + (i & 3); }

struct Unit { int pm, pn, pb; };
struct Gemm { const bf16_t* A; const bf16_t* Bt; int M, N, K; };

struct StaticOrder {
    int nM, nN, nwg, G, c;
    __host__ __device__ void init(int M, int N, int G_, int c_) { nM = M / BM; nN = N / BM; nwg = nM * nN; G = G_; c = c_; }
    __host__ __device__ bool next(int i, Unit& u) const {
        const long L = (long)i * G + c; if (L >= nwg) return false;
        int wgid = (int)L; { const int q = nwg / NXCD, r = nwg % NXCD, xcd = wgid % NXCD, off = wgid / NXCD; wgid = (xcd < r ? xcd * (q + 1) : r * (q + 1) + (xcd - r) * q) + off; }
        const int nig = WGM * nN, gid = wgid / nig, fm = gid * WGM, gsz = (nM - fm) < WGM ? (nM - fm) : WGM;
        u.pm = fm + ((wgid % nig) % gsz); u.pn = (wgid % nig) / gsz; u.pb = u.pn; return true;
    }
    __device__ __forceinline__ void a_ready(const Unit&) const {}
    __device__ __forceinline__ void done(const Unit&) const {}
};

__device__ __forceinline__ unsigned cvt_pk_bf16(float lo, float hi) { unsigned r; asm volatile("v_cvt_pk_bf16_f32 %0, %1, %2" : "=v"(r) : "v"(lo), "v"(hi)); return r; }
typedef float f32x2 __attribute__((ext_vector_type(2)));
typedef float f32x2 __attribute__((ext_vector_type(2)));
typedef unsigned u32x2 __attribute__((ext_vector_type(2)));
__device__ __forceinline__ float fast_sigmoid(float a) { return __builtin_amdgcn_rcpf(1.0f + __builtin_amdgcn_exp2f(-1.4426950408889634f * a)); }
__device__ __forceinline__ float gelu_tanh(float x) { const float u = x * (1.0f + 0.044715f * x * x); return x * __builtin_amdgcn_rcpf(1.0f + __builtin_amdgcn_exp2f(-2.3022081985f * u)); }
__device__ __forceinline__ float bf_lo(unsigned w) { return __uint_as_float(w << 16); }
__device__ __forceinline__ float bf_hi(unsigned w) { return __uint_as_float(w & 0xffff0000u); }

struct EpiBf16S {
    static constexpr bool PERM = true, AFTER_DRAIN = false;
    bf16_t* O; int ldc; int split_cols; size_t split_stride; float scale;
    __device__ __forceinline__ void operator()(const f32x4 (&acc)[2][2][4][2], const Unit& u, int wr, int wc, int fr, int fq) const {
        const int row0 = u.pm * BM + wr * 64 + fr; int colt = u.pn * BM; bf16_t* base = O;
        if (split_cols) { const int t = colt / split_cols; base += (size_t)t * split_stride; colt -= t * split_cols; }
        const int col0 = colt + wc * 32 + 8 * fq;
#pragma unroll
        for (int ai = 0; ai < 2; ++ai)
#pragma unroll
            for (int m = 0; m < 4; ++m) { bf16_t* rowp = base + (size_t)(row0 + ai * HALF + m * 16) * ldc + col0;
#pragma unroll
                for (int bj = 0; bj < 2; ++bj) { const f32x4 v0 = acc[ai][bj][m][0] * scale, v1 = acc[ai][bj][m][1] * scale;
                    u32x4 w; w.x = cvt_pk_bf16(v0[0], v0[1]); w.y = cvt_pk_bf16(v0[2], v0[3]); w.z = cvt_pk_bf16(v1[0], v1[1]); w.w = cvt_pk_bf16(v1[2], v1[3]);
                    *(u32x4*)(rowp + bj * HALF) = w; } }
    }
};
struct EpiGeluStats {
    static constexpr bool PERM = true, AFTER_DRAIN = false;
    bf16_t* O; int ldc; float* stat; int vt0;
    __device__ __forceinline__ void operator()(const f32x4 (&acc)[2][2][4][2], const Unit& u, int wr, int wc, int fr, int fq) const {
        const int row0 = u.pm * BM + wr * 64 + fr; const int col0 = u.pn * BM + wc * 32 + 8 * fq;
        const bool isv = u.pn >= vt0;
#pragma unroll
        for (int ai = 0; ai < 2; ++ai)
#pragma unroll
            for (int m = 0; m < 4; ++m) { const int row = row0 + ai * HALF + m * 16; bf16_t* rowp = O + (size_t)row * ldc + col0; float s = 0.f, q = 0.f;
#pragma unroll
                for (int bj = 0; bj < 2; ++bj) { f32x4 v0 = acc[ai][bj][m][0], v1 = acc[ai][bj][m][1];
#pragma unroll
                    for (int e = 0; e < 4; ++e) { v0[e] = gelu_tanh(v0[e]); v1[e] = gelu_tanh(v1[e]); s += v0[e] + v1[e]; q += v0[e] * v0[e] + v1[e] * v1[e]; }
                    u32x4 w; w.x = cvt_pk_bf16(v0[0], v0[1]); w.y = cvt_pk_bf16(v0[2], v0[3]); w.z = cvt_pk_bf16(v1[0], v1[1]); w.w = cvt_pk_bf16(v1[2], v1[3]);
                    *(u32x4*)(rowp + bj * HALF) = w; }
                if (isv) { s += __shfl_xor(s, 16); s += __shfl_xor(s, 32); q += __shfl_xor(q, 16); q += __shfl_xor(q, 32);
                    if (fq == 0) *(f32x2*)(stat + ((size_t)row * 32 + (u.pn - vt0) * 4 + wc) * 2) = (f32x2){s, q}; } }
    }
};
struct EpiSwiGLU {
    static constexpr bool PERM = true, AFTER_DRAIN = false;
    bf16_t* O; int ldc;
    __device__ __forceinline__ void operator()(const f32x4 (&acc)[2][2][4][2], const Unit& u, int wr, int wc, int fr, int fq) const {
        const int row0 = u.pm * BM + wr * 64 + fr; const int col0 = u.pn * HALF + wc * 32 + 8 * fq;
#pragma unroll
        for (int ai = 0; ai < 2; ++ai)
#pragma unroll
            for (int m = 0; m < 4; ++m) { bf16_t* rowp = O + (size_t)(row0 + ai * HALF + m * 16) * ldc + col0;
                f32x4 h0, h1;
#pragma unroll
                for (int e = 0; e < 4; ++e) { const float g0 = acc[ai][0][m][0][e], g1 = acc[ai][0][m][1][e];
                    h0[e] = g0 * fast_sigmoid(g0) * acc[ai][1][m][0][e]; h1[e] = g1 * fast_sigmoid(g1) * acc[ai][1][m][1][e]; }
                u32x4 w; w.x = cvt_pk_bf16(h0[0], h0[1]); w.y = cvt_pk_bf16(h0[2], h0[3]); w.z = cvt_pk_bf16(h1[0], h1[1]); w.w = cvt_pk_bf16(h1[2], h1[3]);
                *(u32x4*)rowp = w; }
    }
};
__device__ __forceinline__ unsigned pk4_fp8(float a, float b, float c, float d) {
    a = __builtin_amdgcn_fmed3f(a, -448.f, 448.f); b = __builtin_amdgcn_fmed3f(b, -448.f, 448.f); c = __builtin_amdgcn_fmed3f(c, -448.f, 448.f); d = __builtin_amdgcn_fmed3f(d, -448.f, 448.f);
    int w = __builtin_amdgcn_cvt_pk_fp8_f32(a, b, 0, false); w = __builtin_amdgcn_cvt_pk_fp8_f32(c, d, w, true); return (unsigned)w; }
struct EpiSwiGLU8 {
    static constexpr bool PERM = true, AFTER_DRAIN = false;
    unsigned char* O; int ldc; float inv, so;
    __device__ __forceinline__ void operator()(const f32x4 (&acc)[2][2][4][2], const Unit& u, int wr, int wc, int fr, int fq) const {
        const int row0 = u.pm * BM + wr * 64 + fr; const int col0 = u.pn * HALF + wc * 32 + 8 * fq;
#pragma unroll
        for (int ai = 0; ai < 2; ++ai)
#pragma unroll
            for (int m = 0; m < 4; ++m) { unsigned char* rowp = O + (size_t)(row0 + ai * HALF + m * 16) * ldc + col0;
                f32x4 h0, h1;
#pragma unroll
                for (int e = 0; e < 4; ++e) { const float g0 = acc[ai][0][m][0][e] * inv, g1 = acc[ai][0][m][1][e] * inv;
                    h0[e] = g0 * fast_sigmoid(g0) * (acc[ai][1][m][0][e] * (inv * so)); h1[e] = g1 * fast_sigmoid(g1) * (acc[ai][1][m][1][e] * (inv * so)); }
                u32x2 w; w.x = pk4_fp8(h0[0], h0[1], h0[2], h0[3]); w.y = pk4_fp8(h1[0], h1[1], h1[2], h1[3]);
                *(u32x2*)rowp = w; }
    }
};
struct EpiResF32 {
    static constexpr bool PERM = false, AFTER_DRAIN = false;
    const float* base; float* out; int ldc; float alpha;
    __device__ __forceinline__ void operator()(const f32x4 (&acc)[2][2][4][2], const Unit& u, int wr, int wc, int fr, int fq) const {
        const int row0 = u.pm * BM + wr * 64 + fr; const int col0 = u.pn * BM + wc * 32 + 4 * fq;
#pragma unroll
        for (int ai = 0; ai < 2; ++ai)
#pragma unroll
            for (int m = 0; m < 4; ++m) { const size_t off = (size_t)(row0 + ai * HALF + m * 16) * ldc + col0;
#pragma unroll
                for (int bj = 0; bj < 2; ++bj)
#pragma unroll
                    for (int n = 0; n < 2; ++n) { const f32x4 b = *(const f32x4*)(base + off + bj * HALF + n * 16); *(f32x4*)(out + off + bj * HALF + n * 16) = b * alpha + acc[ai][bj][m][n]; } }
    }
};
struct EpiPLE {
    static constexpr bool PERM = false, AFTER_DRAIN = false;
    const float* x; const bf16_t* pw; float* outF; bf16_t* outB; int ldc;
    __device__ __forceinline__ void operator()(const f32x4 (&acc)[2][2][4][2], const Unit& u, int wr, int wc, int fr, int fq) const {
        const int row0 = u.pm * BM + wr * 64 + fr; const int col0 = u.pn * BM + wc * 32 + 4 * fq;
#pragma unroll
        for (int ai = 0; ai < 2; ++ai)
#pragma unroll
            for (int m = 0; m < 4; ++m) { const size_t off = (size_t)(row0 + ai * HALF + m * 16) * ldc + col0;
#pragma unroll
                for (int bj = 0; bj < 2; ++bj)
#pragma unroll
                    for (int n = 0; n < 2; ++n) { const size_t o2 = off + bj * HALF + n * 16; const f32x4 xv = *(const f32x4*)(x + o2); const u32x2 pv = *(const u32x2*)(pw + o2);
                        const f32x4 a = acc[ai][bj][m][n]; f32x4 o;
                        o[0] = xv[0] + fast_sigmoid(a[0]) * bf_lo(pv.x); o[1] = xv[1] + fast_sigmoid(a[1]) * bf_hi(pv.x);
                        o[2] = xv[2] + fast_sigmoid(a[2]) * bf_lo(pv.y); o[3] = xv[3] + fast_sigmoid(a[3]) * bf_hi(pv.y);
                        *(f32x4*)(outF + o2) = o;
                        if (outB) { u32x2 w; w.x = cvt_pk_bf16(o[0], o[1]); w.y = cvt_pk_bf16(o[2], o[3]); *(u32x2*)(outB + o2) = w; } } }
    }
};
struct MoeOrder {
    int t[9]; int nN, nwg, G, c;
    __device__ __forceinline__ void init(const int (&ts_)[9], int nN_, int G_, int c_) {
#pragma unroll
        for (int j = 0; j < 9; ++j) t[j] = ts_[j];
        nN = nN_; G = G_; c = c_; nwg = t[8] * nN_; }
    __device__ __forceinline__ bool next(int i, Unit& u) const {
        const long L = (long)i * G + c; if (L >= nwg) return false;
        int wgid = (int)L; { const int q = nwg / NXCD, r = nwg % NXCD, xcd = wgid % NXCD, off = wgid / NXCD; wgid = (xcd < r ? xcd * (q + 1) : r * (q + 1) + (xcd - r) * q) + off; }
        int t0 = t[0], t1 = t[1], e = 0;
#pragma unroll
        for (int j = 1; j < 8; ++j) if (wgid >= t[j] * nN) { t0 = t[j]; t1 = t[j + 1]; e = j; }
        const int nt = t1 - t0, loc = wgid - t0 * nN;
        u.pm = t0 + loc % nt; u.pn = loc / nt; u.pb = e * nN + u.pn; return true;
    }
    __device__ __forceinline__ void a_ready(const Unit&) const {}
    __device__ __forceinline__ void done(const Unit&) const {}
};
template <class Epi, class Sched, bool ALIGN_EPI = false, bool SP2 = false, bool F8 = false>
__device__ __forceinline__ void gemm_phase(PG8_LAS unsigned char* lds, const Gemm g, const Sched& S, const Epi& E) {
    const int tid = opaque_tid(), wid = __builtin_amdgcn_readfirstlane(tid >> 6), lane = tid & 63, wr = wid >> 2, wc = wid & 3, fr = lane & 15, fq = lane >> 4;
    const int K = g.K, nt = K / BK;
    unsigned voffA[2], voffB[2];
#pragma unroll
    for (int i = 0; i < 2; ++i) { int R, C; stage_rc(tid * 16 + i * 8192, R, C); const int Rb = Epi::PERM ? ((R & ~31) + perm32(R & 31)) : R;
        voffA[i] = (unsigned)(R * K + C) * 2u; voffB[i] = (unsigned)(Rb * K + C) * 2u; }
    const size_t kstep = (size_t)(BK * 2);
    const size_t hstep = (size_t)HALF * K * 2;
    const size_t tstep = 2 * hstep;
    const unsigned ldsw = (unsigned)wid * 1024u;
    const int aoff = lds_byte(wr * 64 + fr, fq * 8), boff = lds_byte(wc * 32 + fr, fq * 8);
#define PG8_SA(b, h) (((b) * 2 + (h)) * HTB)
#define PG8_SB(b, h) ((4 + (b) * 2 + (h)) * HTB)
#define PG8_STAGE(bufoff, gbase, voff) do { _Pragma("unroll") for (int _i = 0; _i < 2; ++_i) \
        __builtin_amdgcn_global_load_lds((const unsigned*)((const char*)(gbase) + (voff)[_i]), (PG8_LAS unsigned*)(lds + (bufoff) + ldsw + _i * 8192), 16, 0, 0); } while (0)
#define PG8_LDA(dst, b, h) do { _Pragma("unroll") for (int m = 0; m < 4; ++m) { \
        if constexpr (F8) { const i32x4_t lo_ = *(const PG8_LAS i32x4_t*)(lds + PG8_SA(b, h) + aoff + m * 2048), hi_ = *(const PG8_LAS i32x4_t*)(lds + PG8_SA(b, h) + aoff + m * 2048 + 1024); \
                            dst##8[m] = __builtin_shufflevector(lo_, hi_, 0, 1, 2, 3, 4, 5, 6, 7); } \
        else { _Pragma("unroll") for (int k = 0; k < 2; ++k) dst[m][k] = *(const PG8_LAS bf16x8*)(lds + PG8_SA(b, h) + aoff + m * 2048 + k * 1024); } } } while (0)
#define PG8_LDB(dst, b, h) do { _Pragma("unroll") for (int n = 0; n < 2; ++n) { \
        if constexpr (F8) { const i32x4_t lo_ = *(const PG8_LAS i32x4_t*)(lds + PG8_SB(b, h) + boff + n * 2048), hi_ = *(const PG8_LAS i32x4_t*)(lds + PG8_SB(b, h) + boff + n * 2048 + 1024); \
                            dst##8[n] = __builtin_shufflevector(lo_, hi_, 0, 1, 2, 3, 4, 5, 6, 7); } \
        else { _Pragma("unroll") for (int k = 0; k < 2; ++k) dst[n][k] = *(const PG8_LAS bf16x8*)(lds + PG8_SB(b, h) + boff + n * 2048 + k * 1024); } } } while (0)
#define PG8_MMA(ai, bj, At, Bt) do { __builtin_amdgcn_s_setprio(1); _Pragma("unroll") for (int m = 0; m < 4; ++m) _Pragma("unroll") for (int n = 0; n < 2; ++n) { \
        if constexpr (F8) asm volatile("v_mfma_f32_16x16x128_f8f6f4 %0, %1, %2, %0" : "+v"(acc[ai][bj][m][n]) : "v"(Bt##8[n]), "v"(At##8[m]));   \
        else { _Pragma("unroll") for (int k = 0; k < 2; ++k) acc[ai][bj][m][n] = __builtin_amdgcn_mfma_f32_16x16x32_bf16(Bt[n][k], At[m][k], acc[ai][bj][m][n], 0, 0, 0); } } \
        __builtin_amdgcn_s_setprio(0); } while (0)
#define PG8_WAIT_V(n) asm volatile("s_waitcnt vmcnt(" #n ")" ::: "memory")
#define PG8_WAIT_L(n) asm volatile("s_waitcnt lgkmcnt(" #n ")" ::: "memory")
#define PG8_BAR __builtin_amdgcn_s_barrier()
#define PG8_SCHED __builtin_amdgcn_sched_barrier(0)
    Unit cur, nxt; int ui = 0;
    if (!S.next(0, cur)) return;
    f32x4 acc[2][2][4][2];
#pragma unroll
    for (int a = 0; a < 2; ++a)
#pragma unroll
        for (int b = 0; b < 2; ++b)
#pragma unroll
            for (int m = 0; m < 4; ++m)
#pragma unroll
                for (int n = 0; n < 2; ++n) acc[a][b][m][n] = (f32x4){0.f, 0.f, 0.f, 0.f};
    bf16x8 At[4][2], B0[2][2], B1[2][2];
    i32x8_t At8[4], B08[2], B18[2];
    const char* cA = (const char*)g.A + (size_t)cur.pm * tstep; const char* cB = (const char*)g.Bt + (size_t)cur.pb * tstep;
    S.a_ready(cur);
    if constexpr (SP2) {
        PG8_STAGE(PG8_SB(0, 0), cB, voffB); PG8_STAGE(PG8_SB(0, 1), cB + hstep, voffB); PG8_STAGE(PG8_SA(0, 0), cA, voffA); PG8_STAGE(PG8_SA(0, 1), cA + hstep, voffA);
        if (wr == 1) PG8_BAR;
        PG8_WAIT_V(2); PG8_BAR;
        PG8_STAGE(PG8_SB(1, 0), cB + kstep, voffB); PG8_STAGE(PG8_SA(1, 0), cA + kstep, voffA); PG8_STAGE(PG8_SB(1, 1), cB + hstep + kstep, voffB);
        PG8_WAIT_V(6); PG8_BAR;
    } else {
        PG8_STAGE(PG8_SB(0, 0), cB, voffB); PG8_STAGE(PG8_SA(0, 0), cA, voffA); PG8_STAGE(PG8_SB(0, 1), cB + hstep, voffB); PG8_STAGE(PG8_SA(0, 1), cA + hstep, voffA);
        if (wr == 1) PG8_BAR;
        PG8_WAIT_V(4); PG8_BAR;
        PG8_STAGE(PG8_SB(1, 0), cB + kstep, voffB); PG8_STAGE(PG8_SA(1, 0), cA + kstep, voffA); PG8_STAGE(PG8_SB(1, 1), cB + hstep + kstep, voffB);
        PG8_WAIT_V(6); PG8_BAR;
    }
    for (;;) {
        const bool has_next = S.next(ui + 1, nxt);
        const char* nA = has_next ? (const char*)g.A + (size_t)nxt.pm * tstep : cA; const char* nB = has_next ? (const char*)g.Bt + (size_t)nxt.pb * tstep : cB;
        for (int t = 0; t < nt; t += 2) {
            const bool last = (t == nt - 2);
            const char* a1 = cA + (size_t)(t + 1) * kstep;
            const char* a2 = last ? nA : cA + (size_t)(t + 2) * kstep; const char* b2 = last ? nB : cB + (size_t)(t + 2) * kstep;
            const char* a3 = a2 + kstep; const char* b3 = b2 + kstep;
            if (last && has_next) S.a_ready(nxt);
            if constexpr (SP2) {
            PG8_LDB(B0, 0, 0); PG8_LDB(B1, 0, 1); PG8_SCHED; PG8_LDA(At, 0, 0); PG8_STAGE(PG8_SA(1, 1), a1 + hstep, voffA);
            PG8_WAIT_V(8); PG8_WAIT_L(0); PG8_BAR; PG8_MMA(0, 0, At, B0); PG8_MMA(0, 1, At, B1); PG8_BAR; PG8_SCHED;
            PG8_LDA(At, 0, 1); PG8_STAGE(PG8_SB(0, 0), b2, voffB); PG8_STAGE(PG8_SB(0, 1), b2 + hstep, voffB); PG8_STAGE(PG8_SA(0, 0), a2, voffA);
            PG8_WAIT_V(8); PG8_WAIT_L(0); PG8_BAR; PG8_MMA(1, 0, At, B0); PG8_MMA(1, 1, At, B1); PG8_BAR; PG8_SCHED;
            PG8_LDB(B0, 1, 0); PG8_LDB(B1, 1, 1); PG8_SCHED; PG8_LDA(At, 1, 0); PG8_STAGE(PG8_SA(0, 1), a2 + hstep, voffA);
            PG8_WAIT_V(8); PG8_WAIT_L(0); PG8_BAR; PG8_MMA(0, 0, At, B0); PG8_MMA(0, 1, At, B1); PG8_BAR; PG8_SCHED;
            PG8_LDA(At, 1, 1); PG8_STAGE(PG8_SB(1, 0), b3, voffB); PG8_STAGE(PG8_SB(1, 1), b3 + hstep, voffB); PG8_STAGE(PG8_SA(1, 0), a3, voffA);
            PG8_WAIT_V(8); PG8_WAIT_L(0); PG8_BAR; PG8_MMA(1, 0, At, B0); PG8_MMA(1, 1, At, B1); PG8_BAR; PG8_SCHED;
            } else {
            PG8_LDB(B0, 0, 0); PG8_SCHED; PG8_LDA(At, 0, 0); PG8_STAGE(PG8_SA(1, 1), a1 + hstep, voffA);
            PG8_WAIT_L(8); PG8_BAR; PG8_WAIT_L(0); PG8_MMA(0, 0, At, B0); PG8_BAR; PG8_SCHED;
            PG8_LDB(B1, 0, 1); PG8_STAGE(PG8_SB(0, 0), b2, voffB);
            PG8_BAR; PG8_WAIT_L(0); PG8_MMA(0, 1, At, B1); PG8_BAR;
            PG8_LDA(At, 0, 1); PG8_STAGE(PG8_SA(0, 0), a2, voffA);
            PG8_BAR; PG8_WAIT_L(0); PG8_MMA(1, 0, At, B0); PG8_BAR; PG8_SCHED;
            PG8_STAGE(PG8_SB(0, 1), b2 + hstep, voffB);
            PG8_WAIT_V(6); PG8_BAR; PG8_MMA(1, 1, At, B1); PG8_BAR;
            PG8_LDB(B0, 1, 0); PG8_SCHED; PG8_LDA(At, 1, 0); PG8_STAGE(PG8_SA(0, 1), a2 + hstep, voffA);
            PG8_WAIT_L(8); PG8_BAR; PG8_WAIT_L(0); PG8_MMA(0, 0, At, B0); PG8_BAR; PG8_SCHED;
            PG8_LDB(B1, 1, 1); PG8_STAGE(PG8_SB(1, 0), b3, voffB);
            PG8_BAR; PG8_WAIT_L(0); PG8_MMA(0, 1, At, B1); PG8_BAR;
            PG8_LDA(At, 1, 1); PG8_STAGE(PG8_SA(1, 0), a3, voffA);
            PG8_BAR; PG8_WAIT_L(0); PG8_MMA(1, 0, At, B0); PG8_BAR; PG8_SCHED;
            PG8_STAGE(PG8_SB(1, 1), b3 + hstep, voffB);
            PG8_WAIT_V(6); PG8_BAR; PG8_MMA(1, 1, At, B1); PG8_BAR;
            }
        }
        if constexpr (ALIGN_EPI) { if (wr == 0) PG8_BAR; }
        if constexpr (F8) asm volatile("s_nop 15\n\ts_nop 7" ::: "memory");
        if constexpr (!Epi::AFTER_DRAIN) { E(acc, cur, wr, wc, fr, fq); S.done(cur); }
        if (!has_next) break;
#pragma unroll
        for (int a = 0; a < 2; ++a)
#pragma unroll
            for (int b = 0; b < 2; ++b)
#pragma unroll
                for (int m = 0; m < 4; ++m)
#pragma unroll
                    for (int n = 0; n < 2; ++n) acc[a][b][m][n] = (f32x4){0.f, 0.f, 0.f, 0.f};
        cur = nxt; cA = nA; cB = nB; ++ui;
        if constexpr (ALIGN_EPI) { if (wr == 1) PG8_BAR; }
    }
    PG8_WAIT_V(0);
    if constexpr (!ALIGN_EPI) { if (wr == 0) PG8_BAR; }
    PG8_BAR;
    if constexpr (Epi::AFTER_DRAIN) { E.fused(acc, cur, wr, wc, fr, fq, lds, wid, lane); S.done(cur); }
#undef PG8_SA
#undef PG8_SB
#undef PG8_STAGE
#undef PG8_LDA
#undef PG8_LDB
#undef PG8_MMA
#undef PG8_WAIT_V
#undef PG8_WAIT_L
#undef PG8_BAR
#undef PG8_SCHED
}
}
namespace fox {
#define FLAS __attribute__((address_space(3)))
using bf16 = __hip_bfloat16;
typedef short bf16x8 __attribute__((ext_vector_type(8)));
typedef short s16x4 __attribute__((ext_vector_type(4)));
typedef float f32x16 __attribute__((ext_vector_type(16)));
typedef float f32x4 __attribute__((ext_vector_type(4)));
typedef unsigned u32x4 __attribute__((ext_vector_type(4)));
constexpr int D = 128, PITCH = 2048, SQ = 4096, NHD = 16;
constexpr float SCALE = 0.08838834764831845f;
constexpr float THR2 = 11.5415603f;
constexpr int NW = 8, QBLK = 32, KVBLK = 64, QB = NW * QBLK;
constexpr int SHM_V = KVBLK * D * 2, SHM_K = KVBLK * D * 2;
constexpr int OFF_WS = 2 * SHM_V + 2 * SHM_K, OFF_KB = OFF_WS + NW * 64 * 4, LDS_BYTES = OFF_KB + SQ * 4;
#define KSWZ(row, colB) ((row) * 256 + ((colB) ^ (((row) & 7) << 4)))
#define SBAR() __builtin_amdgcn_sched_barrier(0)
__device__ __forceinline__ int v_st(int k, int c) { const int kk = (k & ~0xC) | ((k & 4) << 1) | ((k & 8) >> 1); return ((kk >> 3) * 4 + (c >> 5)) * 512 + ((kk & 7) * 32 + (c & 31)) * 2; }
__device__ __forceinline__ int v_rd_base(int lane) { return ((lane & 3) << 3) | (((lane >> 2) & 3) << 6) | (((lane >> 4) & 1) << 5) | (((lane >> 5) & 1) << 8); }
constexpr int v_rd_off(int d0, int ks, int half) { return d0 * 512 + ks * 4096 + half * 2048; }
__device__ __forceinline__ int crow(int r, int hi) { return (r & 3) + 8 * (r >> 2) + 4 * hi; }
__device__ __forceinline__ unsigned cvtpk(float lo, float hi) { unsigned r; asm volatile("v_cvt_pk_bf16_f32 %0, %1, %2" : "=v"(r) : "v"(lo), "v"(hi)); return r; }
__device__ __forceinline__ bf16x8 load8(const bf16* p) { return *reinterpret_cast<const bf16x8*>(p); }
__device__ __forceinline__ void mask_tile(f32x16& p0, f32x16& p1, int dq) {
    const float NEG = -__builtin_inff();
#pragma unroll
    for (int r = 0; r < 16; ++r) { const int c = (r & 3) + 8 * (r >> 2); if (dq - c < 0) p0[r] = NEG; if (dq - c - 32 < 0) p1[r] = NEG; }
}
__device__ __forceinline__ void partialSM(f32x16& p0, f32x16& p1, const FLAS char* kbp, bool domask, int dq, float& m_reg, float& mn, float& alpha) {
    constexpr float C2 = 1.4426950408889634f * SCALE;
#pragma unroll
    for (int j = 0; j < 4; ++j) { const f32x4 b0 = *(const FLAS f32x4*)(kbp + j * 32), b1 = *(const FLAS f32x4*)(kbp + 128 + j * 32);
#pragma unroll
        for (int e = 0; e < 4; ++e) { p0[4 * j + e] = fmaf(p0[4 * j + e], C2, b0[e]); p1[4 * j + e] = fmaf(p1[4 * j + e], C2, b1[e]); } }
    if (domask) mask_tile(p0, p1, dq);
    float pmax = p0[0];
#pragma unroll
    for (int r = 1; r < 16; ++r) pmax = fmaxf(pmax, p0[r]);
#pragma unroll
    for (int r = 0; r < 16; ++r) pmax = fmaxf(pmax, p1[r]);
    { auto rr = __builtin_amdgcn_permlane32_swap(__float_as_uint(pmax), __float_as_uint(pmax), false, false);
      pmax = fmaxf(__uint_as_float(rr[0]), __uint_as_float(rr[1])); }
    if (__builtin_expect(__all(pmax - m_reg <= THR2), 1)) { mn = m_reg; alpha = 1.f; }
    else { mn = fmaxf(m_reg, pmax); alpha = __builtin_amdgcn_exp2f(m_reg - mn); m_reg = mn; }
#pragma unroll
    for (int r = 0; r < 16; ++r) p0[r] = p0[r] - mn;
#pragma unroll
    for (int r = 0; r < 16; ++r) p1[r] = p1[r] - mn;
#pragma unroll
    for (int r = 0; r < 16; ++r) p0[r] = __builtin_amdgcn_exp2f(p0[r]);
}
__device__ __forceinline__ void finishSM(f32x16& p0, f32x16& p1, float alpha, float& l_reg, bf16x8& pa0, bf16x8& pa1, bf16x8& pa2, bf16x8& pa3) {
#pragma unroll
    for (int r = 0; r < 16; ++r) p1[r] = __builtin_amdgcn_exp2f(p1[r]);
    float ps = 0;
#pragma unroll
    for (int r = 0; r < 16; ++r) ps += p0[r];
#pragma unroll
    for (int r = 0; r < 16; ++r) ps += p1[r];
    { auto rr = __builtin_amdgcn_permlane32_swap(__float_as_uint(ps), __float_as_uint(ps), false, false);
      ps = __uint_as_float(rr[0]) + __uint_as_float(rr[1]); }
    l_reg = l_reg * alpha + ps;
#define PK4(P, B_, OUT) do { unsigned a0 = cvtpk(P[B_+0], P[B_+1]), a1 = cvtpk(P[B_+2], P[B_+3]);                          \
        unsigned b0 = cvtpk(P[B_+4], P[B_+5]), b1 = cvtpk(P[B_+6], P[B_+7]);                                             \
        auto r0 = __builtin_amdgcn_permlane32_swap(a0, b0, false, false); auto r1 = __builtin_amdgcn_permlane32_swap(a1, b1, false, false); \
        u32x4 w = {r0[0], r1[0], r0[1], r1[1]}; OUT = *reinterpret_cast<bf16x8*>(&w); } while (0)
    PK4(p0, 0, pa0); PK4(p0, 8, pa1); PK4(p1, 0, pa2); PK4(p1, 8, pa3);
#undef PK4
}
template <int KB>
__device__ __forceinline__ void qkt(f32x16& p0, f32x16& p1, const char* K_lds, int r32, int hi, const bf16x8* qr) {
    p0 = f32x16{}; p1 = f32x16{};
    const char* kb[4];
#pragma unroll
    for (int dd = 0; dd < 4; ++dd) kb[dd] = K_lds + KB * SHM_K + KSWZ(r32, (dd * 16 + hi * 8) * 2);
#pragma unroll
    for (int d0 = 0; d0 < 8; ++d0) { const char* a = kb[d0 & 3] + (d0 >> 2) * 128;
        bf16x8 b0 = *reinterpret_cast<const bf16x8*>(a);
        bf16x8 b1 = *reinterpret_cast<const bf16x8*>(a + 32 * 256);
        p0 = __builtin_amdgcn_mfma_f32_32x32x16_bf16(b0, qr[d0], p0, 0, 0, 0);
        p1 = __builtin_amdgcn_mfma_f32_32x32x16_bf16(b1, qr[d0], p1, 0, 0, 0);
        if ((d0 & 3) == 3) SBAR(); }
}
template <int VB>
__device__ __forceinline__ void pv_tile(f32x16* o, int vb0, bf16x8 pa0, bf16x8 pa1, bf16x8 pa2, bf16x8 pa3) {
#define TRRD(dst, off) asm volatile("ds_read_b64_tr_b16 %0, %1 offset:%2" : "=&v"(dst) : "v"(vb0), "i"(off) : "memory")
#define PV_D0(d0) do { s16x4 l0, l1, l2, l3, h0, h1, h2, h3; constexpr int b_ = VB * SHM_V + v_rd_off(d0, 0, 0); \
        TRRD(l0, b_); TRRD(h0, b_ + 2048); TRRD(l1, b_ + 4096); TRRD(h1, b_ + 6144); TRRD(l2, b_ + 8192); TRRD(h2, b_ + 10240); TRRD(l3, b_ + 12288); TRRD(h3, b_ + 14336); \
        asm volatile("s_waitcnt lgkmcnt(0)" ::: "memory"); SBAR();   \
        o[d0] = __builtin_amdgcn_mfma_f32_32x32x16_bf16(pa0, (bf16x8){l0[0], l0[1], l0[2], l0[3], h0[0], h0[1], h0[2], h0[3]}, o[d0], 0, 0, 0);   \
        o[d0] = __builtin_amdgcn_mfma_f32_32x32x16_bf16(pa1, (bf16x8){l1[0], l1[1], l1[2], l1[3], h1[0], h1[1], h1[2], h1[3]}, o[d0], 0, 0, 0);   \
        o[d0] = __builtin_amdgcn_mfma_f32_32x32x16_bf16(pa2, (bf16x8){l2[0], l2[1], l2[2], l2[3], h2[0], h2[1], h2[2], h2[3]}, o[d0], 0, 0, 0);   \
        o[d0] = __builtin_amdgcn_mfma_f32_32x32x16_bf16(pa3, (bf16x8){l3[0], l3[1], l3[2], l3[3], h3[0], h3[1], h3[2], h3[3]}, o[d0], 0, 0, 0); } while (0)
    PV_D0(0); PV_D0(1); PV_D0(2); PV_D0(3);
#undef PV_D0
#undef TRRD
}
struct BlockRef { unsigned qo, kvo; int P0; };
struct Seam { bf16x8 qr[8]; bf16x8 st_v0, st_v1, st_k0, st_k1; };
typedef __amdgpu_buffer_rsrc_t rsrc_t;
constexpr unsigned TB = 8192u * PITCH * 2u;
__device__ __forceinline__ bf16x8 bld8(rsrc_t r, unsigned voff, unsigned soff) { return __builtin_bit_cast(bf16x8, __builtin_amdgcn_raw_buffer_load_b128(r, voff, soff, 0)); }
#define VMW() asm volatile("s_waitcnt vmcnt(0)" ::: "memory")
#define VMWN(n) asm volatile("s_waitcnt vmcnt(%0)" :: "i"(n) : "memory")
#define SLOAD_H(kvo_, k0) do { const unsigned ko_ = TB + (kvo_) + (unsigned)(k0) * (PITCH * 2u), vo_ = ko_ + TB;              \
                         S.st_v0 = bld8(rq, goff0, vo_); S.st_v1 = bld8(rq, goff0, vo_ + 32u * PITCH * 2u); S.st_k0 = bld8(rq, goff0, ko_); S.st_k1 = bld8(rq, goff0, ko_ + 32u * PITCH * 2u); } while (0)
#define SWRITE_HK(bf) do { *(bf16x8*)(K_lds + (bf) * SHM_K + kws) = S.st_k0; *(bf16x8*)(K_lds + (bf) * SHM_K + kws + 32 * 256) = S.st_k1; } while (0)
#define SWRITE_HV(bf) do { *(bf16x8*)(V_lds + (bf) * SHM_V + vst0) = S.st_v0; *(bf16x8*)(V_lds + (bf) * SHM_V + vst1) = S.st_v1; } while (0)
#define SWRITE_H(bf) do { SWRITE_HV(bf); SWRITE_HK(bf); } while (0)
__device__ __forceinline__ void fox_prime(const BlockRef& cur, rsrc_t rq, char* lds, Seam& S) {
    const int tid = opaque_tid(), wid = __builtin_amdgcn_readfirstlane(tid >> 6), lane = tid & 63, r32 = lane & 31, hi = lane >> 5;
    const int sr = tid >> 4, sc = (tid & 15) * 8, kws = KSWZ(sr, sc * 2); char* K_lds = lds + 2 * SHM_V;
    const unsigned goff0 = (unsigned)(sr * PITCH + sc) * 2u, qoff = (unsigned)(r32 * PITCH + hi * 8) * 2u;
    { const unsigned qs_ = cur.qo + (unsigned)(wid * QBLK) * (PITCH * 2u);
#pragma unroll
    for (int d0 = 0; d0 < 8; ++d0) S.qr[d0] = bld8(rq, qoff + d0 * 32, qs_); }
    SLOAD_H(cur.kvo, 0); VMW(); SWRITE_HK(0);
    __syncthreads();
}
__device__ __forceinline__ void fox_block(const BlockRef& cur, const BlockRef& nxt, rsrc_t rq, rsrc_t ro, char* lds, Seam& S) {
    const int tid = opaque_tid(), wid = __builtin_amdgcn_readfirstlane(tid >> 6), lane = tid & 63, r32 = lane & 31, hi = lane >> 5;
    const int NT = (cur.P0 + QB - 1) / KVBLK + 1;
    const int qlo = cur.P0 + wid * QBLK, qm = qlo + r32 - 4 * hi;
    char* V_lds = lds; char* K_lds = lds + 2 * SHM_V;
    float* ws = (float*)(lds + OFF_WS) + wid * 64; float* li_l = ws, * al_l = ws + 32;
    const FLAS char* kb_l = (const FLAS char*)(FLAS char*)(lds + OFF_KB) + hi * 16;
    float m_reg = -1e30f, l_reg = 0; f32x16 o[4] = {};
    const int sr = tid >> 4, sc = (tid & 15) * 8, vst0 = v_st(sr, sc), vst1 = v_st(32 + sr, sc), kws = KSWZ(sr, sc * 2);
    const unsigned goff0 = (unsigned)(sr * PITCH + sc) * 2u, qoff = (unsigned)(r32 * PITCH + hi * 8) * 2u;
    const int vb0 = (int)(uintptr_t)V_lds + v_rd_base(lane);
#define RESC(a) do { if (__any((a) < 1.f)) { if (hi == 0) al_l[r32] = (a); asm volatile("s_waitcnt lgkmcnt(0)" ::: "memory");              \
                     _Pragma("unroll") for (int d_ = 0; d_ < 4; ++d_) _Pragma("unroll") for (int r = 0; r < 16; ++r) o[d_][r] *= al_l[crow(r, hi)]; } } while (0)
#define KBASE(t) ((t) * KVBLK)
#define PSM(P0_, P1_, mnX, alX, t) do { const int kb_ = KBASE(t); partialSM(P0_, P1_, kb_l + kb_ * 4, (kb_ + KVBLK - 1 > qlo), qm - kb_, m_reg, mnX, alX); } while (0)
    constexpr int NQL = 8;
#define SEAM_K0() do { VMWN(NQL); SWRITE_HK(0); SBAR(); } while (0)
    f32x16 pA0, pA1, pB0, pB1; float mnA, mnB, alA, alB; bf16x8 pa0, pa1, pa2, pa3;
    SWRITE_HV(0); SBAR();
    if (NT > 1) { SLOAD_H(cur.kvo, KBASE(1)); }
    SBAR(); qkt<0>(pA0, pA1, K_lds, r32, hi, S.qr);
    PSM(pA0, pA1, mnA, alA, 0);
    if (NT > 1) { VMW(); SWRITE_H(1); }
    __syncthreads();
#define HALF_STEP(PX0, PX1, mnX, alX, PY0, PY1, alY, t, KB, VB, SB) do {                                                      \
        SBAR(); qkt<KB>(PX0, PX1, K_lds, r32, hi, S.qr);                                             \
        finishSM(PY0, PY1, alY, l_reg, pa0, pa1, pa2, pa3); SBAR();                                                           \
        if ((t) + 1 < NT) { SLOAD_H(cur.kvo, KBASE((t) + 1)); SBAR(); }                                               \
        pv_tile<VB>(o, vb0, pa0, pa1, pa2, pa3); PSM(PX0, PX1, mnX, alX, (t));                                        \
        __syncthreads();                                                                                                      \
        if ((t) + 1 < NT) { VMW(); SWRITE_H(SB); }                                                                          \
        RESC(alX); __syncthreads(); } while (0)
    for (int t = 1; t + 1 < NT; t += 2) {
        HALF_STEP(pB0, pB1, mnB, alB, pA0, pA1, alA, t, 1, 0, 0);
        HALF_STEP(pA0, pA1, mnA, alA, pB0, pB1, alB, t + 1, 0, 1, 1);
    }
    const bool even = (NT & 1) == 0;
    if (even) { SBAR(); qkt<1>(pB0, pB1, K_lds, r32, hi, S.qr); SBAR(); }
    SLOAD_H(nxt.kvo, 0); SBAR();
    { const unsigned qs_ = nxt.qo + (unsigned)(wid * QBLK) * (PITCH * 2u);
#pragma unroll
    for (int d0 = 0; d0 < 8; ++d0) S.qr[d0] = bld8(rq, qoff + d0 * 32, qs_); }
    SBAR();
    finishSM(pA0, pA1, alA, l_reg, pa0, pa1, pa2, pa3); SBAR();
    pv_tile<0>(o, vb0, pa0, pa1, pa2, pa3);
    if (even) { PSM(pB0, pB1, mnB, alB, NT - 1); __syncthreads(); RESC(alB);
        finishSM(pB0, pB1, alB, l_reg, pa0, pa1, pa2, pa3); SBAR(); pv_tile<1>(o, vb0, pa0, pa1, pa2, pa3); }
    SBAR(); SEAM_K0();
    if (hi == 0) li_l[r32] = l_reg; asm volatile("s_waitcnt lgkmcnt(0)" ::: "memory");
    float rli[16];
#pragma unroll
    for (int r = 0; r < 16; ++r) rli[r] = __builtin_amdgcn_rcpf(li_l[crow(r, hi)]);
    const unsigned os_ = cur.qo + (unsigned)(wid * QBLK) * (PITCH * 2u), ooff = (unsigned)(4 * hi * PITCH + r32) * 2u;
#pragma unroll
    for (int r = 0; r < 16; ++r) { const unsigned or_ = os_ + (unsigned)((r & 3) + 8 * (r >> 2)) * (PITCH * 2u);
#pragma unroll
        for (int d0 = 0; d0 < 4; ++d0) { const float v = o[d0][r] * rli[r];
            const float vn = __shfl_xor(v, 1);
            if ((r32 & 1) == 0) __builtin_amdgcn_raw_buffer_store_b32(cvtpk(v, vn), ro, ooff + d0 * 64, or_, 0); } }
    __syncthreads();
#undef RESC
#undef KBASE
#undef PSM
#undef SEAM_K0
#undef HALF_STEP
}
#undef VMW
#undef VMWN
#undef SLOAD_H
#undef SWRITE_HK
#undef SWRITE_HV
#undef SWRITE_H
__device__ __forceinline__ BlockRef mkref(int bh, int qb) { BlockRef r; const unsigned row0 = (unsigned)(bh / NHD) * SQ, h = (unsigned)(bh % NHD);
    r.kvo = (row0 * PITCH + h * D) * 2u; r.qo = r.kvo + (unsigned)qb * (QB * PITCH * 2u); r.P0 = qb * QB; return r; }
__device__ __forceinline__ void load_kb(char* lds, const float* kbias, int bh, int tid) {
    const char* src = (const char*)(kbias + (size_t)bh * SQ);
#pragma unroll
    for (int i = 0; i < SQ / 4 / 512; ++i) { const unsigned off = (unsigned)(tid + 512 * i) * 16u; *(f32x4*)(lds + OFF_KB + off) = *(const f32x4*)(src + off); }
}
__device__ __forceinline__ void fox_phase(char* lds, const bf16* QKV, bf16* O, const float* kbias, int vcu, int G) {
    const rsrc_t rq = __builtin_amdgcn_make_buffer_rsrc((void*)QKV, 0, (int)(3u * TB), 0x00020000), ro = __builtin_amdgcn_make_buffer_rsrc((void*)O, 0, (int)TB, 0x00020000);
    constexpr int NQB = SQ / QB, NX = NQB / 2, TOTAL = NX * 32;
    int L = vcu; if (L >= TOTAL) return;
    const int tid = opaque_tid();
    int bh = L / NX, y = L % NX, pass = 0;
    load_kb(lds, kbias, bh, tid);
    BlockRef cur = mkref(bh, y);
    Seam S;
    fox_prime(cur, rq, lds, S);
    for (;;) {
        const bool more_pass = pass == 0, more_item = L + G < TOTAL, last = !more_pass && !more_item;
        int Ln = L, bhn = bh, yn = y, passn = pass + 1;
        if (!more_pass) { passn = 0; Ln = more_item ? L + G : L; bhn = Ln / NX; yn = Ln % NX; }
        const BlockRef nxt = last ? cur : mkref(bhn, passn ? NQB - 1 - yn : yn);
        fox_block(cur, nxt, rq, ro, lds, S);
        if (last) break;
        if (bhn != bh) { load_kb(lds, kbias, bhn, tid); __syncthreads(); }
        cur = nxt; L = Ln; bh = bhn; y = yn; pass = passn;
    }
}
#undef KSWZ
#undef SBAR
#undef FLAS
}
constexpr int NWAVES = 8;
constexpr int NB = 2, SEQ = 4096, T = NB * SEQ, DM = 2048, NH = 16, HD = 128, FF = 5632, NE = 8, FE = 7168, PD = 256, GCH = 128, GG = 16;
constexpr int NQKV = 3 * DM, WIN_LD = 3 * DM + NH;
constexpr int MOE_ROWS = 18432;
constexpr float LN_EPS = 1e-5f, ALPHA = 1.41421356237309515f;
constexpr float LOG2E = 1.4426950408889634f;
constexpr int N_PHASES = 18;
#ifndef CONV_IN_P5
#define CONV_IN_P5 1
#endif
#ifndef CONV_IN_P14
#define CONV_IN_P14 1
#endif
#ifndef P5_GEMM_16THS
#define P5_GEMM_16THS 10
#endif
#ifndef P14_GEMM_16THS
#define P14_GEMM_16THS 13
#endif
constexpr float XS_SCALE = 16.f, WGU_SCALE = 32.f, H_SCALE = 8.f, WDN_SCALE = 128.f, WQKV_SCALE = 64.f;
#ifndef MK_N_LAUNCHES
#define MK_N_LAUNCHES 1
#endif

constexpr size_t MiB = 1u << 20;
constexpr size_t WS_CTL = 0, CTL_ZERO_BYTES = 1 * MiB;
constexpr size_t WS_WQKV = 2 * MiB, WS_WO = 26 * MiB, WS_WGU = 34 * MiB, WS_WDN = 78 * MiB, WS_WPG = 100 * MiB, WS_WPP = 116 * MiB, WS_WGMI = 118 * MiB, WS_WSB = 134 * MiB,
                 WS_WGMO = 135 * MiB, WS_WMGU = 143 * MiB, WS_WMDN = 591 * MiB;
constexpr size_t WS_X0B = 815 * MiB, WS_QKV = 847 * MiB, WS_O = 943 * MiB, WS_PRE = 975 * MiB, WS_X1F = 1039 * MiB, WS_X1B = 1103 * MiB, WS_HB = 1135 * MiB, WS_X2F = 1223 * MiB,
                 WS_X2B = 1287 * MiB, WS_PW = 1319 * MiB, WS_X3F = 1383 * MiB, WS_X3B = 1447 * MiB, WS_UV = 1479 * MiB, WS_VSTAT = 1543 * MiB, WS_YB = 1545 * MiB, WS_X4F = 1577 * MiB,
                 WS_X4B = 1641 * MiB, WS_XS = 1673 * MiB, WS_HM = 1745 * MiB, WS_YS = 1997 * MiB, WS_X5F = 2069 * MiB, WS_X5B = 2133 * MiB, WS_PB = 2165 * MiB, WS_LOGF = 2173 * MiB,
                 WS_KBIAS = 2174 * MiB, WS_ROUTE = 2175 * MiB, WS_END = 2176 * MiB;
static_assert(WS_WMGU + (size_t)NE * 2 * FE * DM * 2 == WS_WMDN && WS_WMDN + (size_t)NE * DM * FE * 2 == WS_X0B, "weight map");
static_assert(WS_HM + (size_t)MOE_ROWS * FE * 2 == WS_YS && WS_HB + (size_t)T * FF * 2 == WS_X2F, "activation map");
constexpr size_t RT_E = 0, RT_POS = 65536, RT_G = 131072, RT_LIST = 196608;
constexpr int CW_TMO = 0, CW_CODE = 1, CW_CNT = 64  , CW_BAR = 4096;

constexpr int RING_BYTES = 131072, LDSCTL_OFF = RING_BYTES, MISC_OFF = LDSCTL_OFF + 320, LDS_BYTES = 147456;

#define GAS __attribute__((address_space(1)))
#define LAS __attribute__((address_space(3)))
typedef unsigned short bf16;
typedef unsigned v4u __attribute__((ext_vector_type(4)));
typedef unsigned v2u __attribute__((ext_vector_type(2)));
typedef float f32x4 __attribute__((ext_vector_type(4)));
typedef float f32x2 __attribute__((ext_vector_type(2)));
typedef short bf16x8 __attribute__((ext_vector_type(8)));
typedef float f32x16 __attribute__((ext_vector_type(16)));
typedef short s16x4 __attribute__((ext_vector_type(4)));
typedef GAS unsigned gu32;
#define RLX_AGENT __ATOMIC_RELAXED, __HIP_MEMORY_SCOPE_AGENT
#define LDS_WAIT() asm volatile("s_waitcnt lgkmcnt(0)" ::: "memory")
#define VM_WAIT() asm volatile("s_waitcnt vmcnt(0)" ::: "memory")
__device__ __forceinline__ unsigned pk2(float lo, float hi) { unsigned r; asm volatile("v_cvt_pk_bf16_f32 %0, %1, %2" : "=v"(r) : "v"(lo), "v"(hi)); return r; }
__device__ __forceinline__ float bflo(unsigned w) { return __uint_as_float(w << 16); }
__device__ __forceinline__ float bfhi(unsigned w) { return __uint_as_float(w & 0xffff0000u); }
__device__ __forceinline__ float wave_sum(float v) {
#pragma unroll
    for (int o = 1; o < 64; o <<= 1) v += __shfl_xor(v, o);
    return v;
}
#define XB_TMO      128
#define XB_XCNT(j)  (256  + 64 * (j))
#define XB_XSUB(j)  (1280 + 64 * (j))
#define XB_XGEN(j)  (2304 + 64 * (j))
#define XB_TOP      3328
#define XB_TOPGEN   3392
#define XCD_BAR_WORDS 3456
#define XB_SPIN_CAP (1u << 18)

__device__ __forceinline__ unsigned xb_ld(unsigned* p)              { return __hip_atomic_load(p, __ATOMIC_RELAXED, __HIP_MEMORY_SCOPE_AGENT); }
__device__ __forceinline__ unsigned xb_add(unsigned* p, unsigned v) { return __hip_atomic_fetch_add(p, v, __ATOMIC_RELAXED, __HIP_MEMORY_SCOPE_AGENT); }
__device__ __forceinline__ unsigned xb_xcc_id() { return (unsigned)__builtin_amdgcn_s_getreg((3 << 11) | 20) & 0xFu; }
#define XB_SPIN(cond, bar) do { unsigned _sp = 0; while (cond) { __builtin_amdgcn_s_sleep(1); \
    if ((++_sp & 255u) == 0u) { if (xb_ld(&(bar)[XB_TMO])) break; if (_sp > XB_SPIN_CAP) { atomicAdd(&(bar)[XB_TMO], 1u); break; } } } } while (0)

struct XcdBarrier {
    unsigned* bar; unsigned x;
    volatile LAS unsigned* st;
};

__device__ __forceinline__ XcdBarrier xcd_barrier_post(unsigned* bar, volatile LAS unsigned* st) {
    XcdBarrier b; b.bar = bar; b.x = xb_xcc_id(); b.st = st;
    if (threadIdx.x == 0) (void)xb_add(&bar[XB_XCNT(b.x)], 1u);
    return b;
}
__device__ __forceinline__ void xcd_barrier_complete(unsigned* bar, unsigned x, unsigned& nloc, unsigned& nx) {
    const unsigned G = gridDim.x * gridDim.y * gridDim.z;
    unsigned sum, cnt, mine, sp = 0u;
    for (;;) {
        sum = 0u; cnt = 0u; mine = 0u;
#pragma unroll
        for (unsigned j = 0; j < 16; ++j) { const unsigned c = xb_ld(&bar[XB_XCNT(j)]); sum += c; cnt += (c > 0u) ? 1u : 0u; mine = (j == x) ? c : mine; }
        if (sum == G) break;
        __builtin_amdgcn_s_sleep(1);
        if ((++sp & 255u) == 0u) { if (xb_ld(&bar[XB_TMO])) break; if (sp > XB_SPIN_CAP) { atomicAdd(&bar[XB_TMO], 1u); break; } }
    }
    nloc = mine > 0u ? mine : 1u; nx = cnt > 0u ? cnt : 1u;
}

__device__ __forceinline__ void xcd_barrier(const XcdBarrier& b) {
    asm volatile("s_waitcnt vmcnt(0)" ::: "memory");
    __syncthreads();
    if (threadIdx.x == 0) {
        unsigned* bar = b.bar;
        __builtin_amdgcn_s_waitcnt(0);
        unsigned nloc = b.st[0], nx = b.st[1];
        if (nloc == 0u) { xcd_barrier_complete(bar, b.x, nloc, nx); b.st[0] = nloc; b.st[1] = nx; }
        const unsigned old = xb_add(&bar[XB_XSUB(b.x)], 1u);
        const unsigned gen = old / nloc;
        if (old + 1u == (gen + 1u) * nloc) {
            __builtin_amdgcn_fence(__ATOMIC_RELEASE, "agent");
            asm volatile("s_waitcnt vmcnt(0)" ::: "memory");
            const unsigned og = xb_add(&bar[XB_TOP], 1u);
            const unsigned tg = og / nx;
            if (og + 1u == (tg + 1u) * nx) xb_add(&bar[XB_TOPGEN], 1u);
            else XB_SPIN(xb_ld(&bar[XB_TOPGEN]) == tg, bar);
            __builtin_amdgcn_fence(__ATOMIC_ACQUIRE, "agent");
            xb_add(&bar[XB_XGEN(b.x)], 1u);
            asm volatile("s_waitcnt vmcnt(0)" ::: "memory");
        } else {
            XB_SPIN(xb_ld(&bar[XB_XGEN(b.x)]) == gen, bar);
            __builtin_amdgcn_fence(__ATOMIC_ACQUIRE, "agent");
            asm volatile("s_waitcnt vmcnt(0)" ::: "memory");
        }
    }
    __syncthreads();
}
__device__ __forceinline__ void transpose_item(const float* W, int ldw, int k0, int n0, bf16* WT, int K, int dr0, LAS float* scr, int lane) {
    { const int lr = lane >> 3, lc = (lane & 7) * 4; f32x4 v[8];
#pragma unroll
      for (int i = 0; i < 8; ++i) v[i] = *(const f32x4*)(W + (size_t)(k0 + lr + 8 * i) * ldw + n0 + lc);
#pragma unroll
      for (int i = 0; i < 8; ++i) { LAS float* d = scr + (lr + 8 * i) * 33 + lc; d[0] = v[i][0]; d[1] = v[i][1]; d[2] = v[i][2]; d[3] = v[i][3]; } }
    LDS_WAIT(); asm volatile("" ::: "memory");
    const int c = lane & 7;
#pragma unroll
    for (int j = 0; j < 4; ++j) { const int n = (lane >> 3) + 8 * j; const LAS float* s = scr + (8 * c) * 33 + n;
        v4u o; o.x = pk2(s[0 * 33], s[1 * 33]); o.y = pk2(s[2 * 33], s[3 * 33]); o.z = pk2(s[4 * 33], s[5 * 33]); o.w = pk2(s[6 * 33], s[7 * 33]);
        *(GAS v4u*)(WT + (size_t)(dr0 + n) * K + k0 + 8 * c) = o; }
    LDS_WAIT(); asm volatile("" ::: "memory");
}
__device__ __forceinline__ unsigned pk4f8(float a, float b, float c, float d) {
    a = __builtin_amdgcn_fmed3f(a, -448.f, 448.f); b = __builtin_amdgcn_fmed3f(b, -448.f, 448.f); c = __builtin_amdgcn_fmed3f(c, -448.f, 448.f); d = __builtin_amdgcn_fmed3f(d, -448.f, 448.f);
    int w = __builtin_amdgcn_cvt_pk_fp8_f32(a, b, 0, false); w = __builtin_amdgcn_cvt_pk_fp8_f32(c, d, w, true); return (unsigned)w; }
__device__ __forceinline__ unsigned pk4f8w(float a, float b, float c, float d) {
    int w = __builtin_amdgcn_cvt_pk_fp8_f32(a, b, 0, false); w = __builtin_amdgcn_cvt_pk_fp8_f32(c, d, w, true); return (unsigned)w; }
__device__ __forceinline__ void t8_load(f32x4 (&v)[2][8], const float* W, int ldw, int k0, int n0, int lane) {
    const int lr = lane >> 3, lc = (lane & 7) * 4;
#pragma unroll
    for (int hf = 0; hf < 2; ++hf)
#pragma unroll
      for (int i = 0; i < 8; ++i) v[hf][i] = *(const f32x4*)(W + (size_t)(k0 + 64 * hf + lr + 8 * i) * ldw + n0 + lc);
}
__device__ __forceinline__ void t8_store(const f32x4 (&v)[2][8], int k0, unsigned char* WT, int K, int dr0, float scale, LAS float* scr, int lane) {
    const int lr = lane >> 3, lc = (lane & 7) * 4;
#pragma unroll
    for (int hf = 0; hf < 2; ++hf) {
#pragma unroll
      for (int i = 0; i < 8; ++i) { LAS float* d = scr + (lr + 8 * i) * 33 + lc; d[0] = v[hf][i][0] * scale; d[1] = v[hf][i][1] * scale; d[2] = v[hf][i][2] * scale; d[3] = v[hf][i][3] * scale; }
      LDS_WAIT(); asm volatile("" ::: "memory");
      const int c = lane & 3;
#pragma unroll
      for (int j = 0; j < 2; ++j) { const int n = (lane >> 2) + 16 * j; const LAS float* s = scr + (16 * c) * 33 + n;
        v4u o; o.x = pk4f8w(s[0 * 33], s[1 * 33], s[2 * 33], s[3 * 33]); o.y = pk4f8w(s[4 * 33], s[5 * 33], s[6 * 33], s[7 * 33]);
        o.z = pk4f8w(s[8 * 33], s[9 * 33], s[10 * 33], s[11 * 33]); o.w = pk4f8w(s[12 * 33], s[13 * 33], s[14 * 33], s[15 * 33]);
        *(GAS v4u*)(WT + (size_t)(dr0 + n) * K + k0 + 64 * hf + 16 * c) = o; }
      LDS_WAIT(); asm volatile("" ::: "memory");
    }
}
__device__ __forceinline__ void transpose_item8(const float* W, int ldw, int k0, int n0, unsigned char* WT, int K, int dr0, float scale, LAS float* scr, int lane) {
    f32x4 v[2][8]; t8_load(v, W, ldw, k0, n0, lane); t8_store(v, k0, WT, K, dr0, scale, scr, lane);
}
__device__ __forceinline__ int gu_row(int n, int F) { const int isu = n >= F ? 1 : 0, j = n - isu * F; return (j >> 7) * 256 + isu * 128 + (j & 127); }
__device__ __forceinline__ void tile_bf16(const float* W, int ldw, int k0, int n0, bf16* WT, int K, int F, int wave, int lane) {
    const float* src = W + (size_t)(k0 + 8 * wave) * ldw + n0 + 4 * lane; f32x4 v[8];
#pragma unroll
    for (int i = 0; i < 8; ++i) v[i] = *(const f32x4*)(src + (size_t)i * ldw);
    const int dr = F ? gu_row(n0 + 4 * lane, F) : n0 + 4 * lane; bf16* dst = WT + (size_t)dr * K + k0 + 8 * wave;
#pragma unroll
    for (int e = 0; e < 4; ++e) { v4u o; o.x = pk2(v[0][e], v[1][e]); o.y = pk2(v[2][e], v[3][e]); o.z = pk2(v[4][e], v[5][e]); o.w = pk2(v[6][e], v[7][e]); *(GAS v4u*)(dst + (size_t)e * K) = o; }
}
__device__ __forceinline__ void tile_f8(const float* W, int ldw, int k0, int n0, unsigned char* WT, int K, int F, float scale, int wave, int lane) {
    const float* src = W + (size_t)(k0 + 16 * wave) * ldw + n0 + 4 * lane; f32x4 v[16];
#pragma unroll
    for (int i = 0; i < 16; ++i) v[i] = *(const f32x4*)(src + (size_t)i * ldw);
    const int dr = F ? gu_row(n0 + 4 * lane, F) : n0 + 4 * lane; unsigned char* dst = WT + (size_t)dr * K + k0 + 16 * wave;
#pragma unroll
    for (int e = 0; e < 4; ++e) { v4u o; o.x = pk4f8(v[0][e] * scale, v[1][e] * scale, v[2][e] * scale, v[3][e] * scale); o.y = pk4f8(v[4][e] * scale, v[5][e] * scale, v[6][e] * scale, v[7][e] * scale);
        o.z = pk4f8(v[8][e] * scale, v[9][e] * scale, v[10][e] * scale, v[11][e] * scale); o.w = pk4f8(v[12][e] * scale, v[13][e] * scale, v[14][e] * scale, v[15][e] * scale); *(GAS v4u*)(dst + (size_t)e * K) = o; }
}
__device__ __forceinline__ float log_sigmoid(float z) { return fminf(z, 0.f) - log1pf(expf(-fabsf(z))); }

__device__ __forceinline__ const void* karg_ptr(int i) {
    const __attribute__((address_space(4))) char* ka = (const __attribute__((address_space(4))) char*)__builtin_amdgcn_kernarg_segment_ptr();
    return *(const void* const __attribute__((address_space(4)))*)(ka + 8 * i);
}
#define KIN(i) ((const float*)karg_ptr(i))
constexpr int I_MGU_C = (DM / 128) * (2 * FE / 32), I_MDN_C = (FE / 128) * (DM / 32), N_MGU_ITEMS = NE * I_MGU_C, N_MDN_ITEMS = NE * I_MDN_C;
__device__ __forceinline__ void conv_mgu(unsigned char* ws, LAS unsigned char* lds, int lane, int wave, int cidx, int ncv) {
    LAS float* scr = (LAS float*)(lds + wave * 8448); const int step = ncv * NWAVES; int r = cidx * NWAVES + wave;
    if (r >= N_MGU_ITEMS) return;
    const float* W0 = KIN(14); unsigned char* D0 = ws + WS_WMGU; constexpr int nb = 2 * FE / 32;
    f32x4 va[2][8], vb[2][8];
    { const int e = r / I_MGU_C, q = r % I_MGU_C; t8_load(va, W0 + (size_t)e * DM * 2 * FE, 2 * FE, (q / nb) * 128, (q % nb) * 32, lane); }
    for (;;) {
        const int rn = r + step; const bool more = rn < N_MGU_ITEMS;
        if (more) { const int e = rn / I_MGU_C, q = rn % I_MGU_C; t8_load(vb, W0 + (size_t)e * DM * 2 * FE, 2 * FE, (q / nb) * 128, (q % nb) * 32, lane); }
        { const int e = r / I_MGU_C, q = r % I_MGU_C; t8_store(va, (q / nb) * 128, D0 + (size_t)e * 2 * FE * DM, DM, gu_row((q % nb) * 32, FE), WGU_SCALE, scr, lane); }
        if (!more) break;
        r = rn;
#pragma unroll
        for (int h = 0; h < 2; ++h)
#pragma unroll
            for (int i = 0; i < 8; ++i) va[h][i] = vb[h][i];
    }
}
__device__ __forceinline__ void conv_mdn(unsigned char* ws, LAS unsigned char* lds, int lane, int wave, int cidx, int ncv) {
    LAS float* scr = (LAS float*)(lds + wave * 8448); const int step = ncv * NWAVES; int r = cidx * NWAVES + wave;
    if (r >= N_MDN_ITEMS) return;
    const float* W0 = KIN(15); unsigned char* D0 = ws + WS_WMDN; constexpr int nb = DM / 32;
    f32x4 va[2][8], vb[2][8];
    { const int e = r / I_MDN_C, q = r % I_MDN_C; t8_load(va, W0 + (size_t)e * FE * DM, DM, (q / nb) * 128, (q % nb) * 32, lane); }
    for (;;) {
        const int rn = r + step; const bool more = rn < N_MDN_ITEMS;
        if (more) { const int e = rn / I_MDN_C, q = rn % I_MDN_C; t8_load(vb, W0 + (size_t)e * FE * DM, DM, (q / nb) * 128, (q % nb) * 32, lane); }
        { const int e = r / I_MDN_C, q = r % I_MDN_C; t8_store(va, (q / nb) * 128, D0 + (size_t)e * DM * FE, FE, (q % nb) * 32, WDN_SCALE, scr, lane); }
        if (!more) break;
        r = rn;
#pragma unroll
        for (int h = 0; h < 2; ++h)
#pragma unroll
            for (int i = 0; i < 8; ++i) va[h][i] = vb[h][i];
    }
}
__device__ __forceinline__ void p0_prologue(unsigned char* ws, LAS unsigned char* lds, int tid, int lane, int wave, int vcu, int G, int parts) {
    const int gw = vcu * NWAVES + wave, NGW = G * NWAVES;
    LAS float* wf = (LAS float*)lds;
    if (parts & 1) {
    for (int i = tid; i < DM * 4; i += NWAVES * 64) { const int k = i >> 2, hq = i & 3; const f32x4 w = *(const f32x4*)(KIN(2) + (size_t)k * WIN_LD + NQKV + hq * 4);
        wf[(hq * 4 + 0) * DM + k] = w[0]; wf[(hq * 4 + 1) * DM + k] = w[1]; wf[(hq * 4 + 2) * DM + k] = w[2]; wf[(hq * 4 + 3) * DM + k] = w[3]; }
    __syncthreads();
    unsigned char* xb = ws + WS_X0B; float* logf_o = (float*)(ws + WS_LOGF);
    for (int tb = gw; tb < T / 4; tb += NGW) {
        float acc[4][16];
#pragma unroll
        for (int a = 0; a < 4; ++a)
#pragma unroll
            for (int h = 0; h < 16; ++h) acc[a][h] = 0.f;
#pragma unroll 1
        for (int j = 0; j < 8; ++j) {
            f32x4 xv[4];
#pragma unroll
            for (int a = 0; a < 4; ++a) { xv[a] = *(const f32x4*)(KIN(0) + (size_t)(4 * tb + a) * DM + 256 * j + 4 * lane);
                *(unsigned*)(xb + (size_t)(4 * tb + a) * DM + 256 * j + 4 * lane) = pk4f8(xv[a][0] * XS_SCALE, xv[a][1] * XS_SCALE, xv[a][2] * XS_SCALE, xv[a][3] * XS_SCALE); }
#pragma unroll
            for (int h = 0; h < 16; ++h) { const f32x4 w = *(const LAS f32x4*)(wf + h * DM + 256 * j + 4 * lane);
#pragma unroll
                for (int a = 0; a < 4; ++a) acc[a][h] += (xv[a][0] * w[0] + xv[a][1] * w[1]) + (xv[a][2] * w[2] + xv[a][3] * w[3]); }
        }
#define RS_STEP(BIT, N) { const bool up_ = (lane & (BIT)) != 0; _Pragma("unroll") for (int i_ = 0; i_ < (N); ++i_) { \
            float& lo_ = acc[i_ >> 4][i_ & 15]; float& hi_ = acc[(i_ + (N)) >> 4][(i_ + (N)) & 15]; \
            const float keep_ = up_ ? hi_ : lo_, give_ = up_ ? lo_ : hi_; lo_ = keep_ + __shfl_xor(give_, (BIT)); } }
        RS_STEP(32, 32) RS_STEP(16, 16) RS_STEP(8, 8) RS_STEP(4, 4) RS_STEP(2, 2) RS_STEP(1, 1)
#undef RS_STEP
        logf_o[(size_t)(4 * tb) * 16 + lane] = log_sigmoid(acc[0][0] + KIN(3)[lane & 15]);
    }
    }
    __syncthreads();
    LAS float* scr = (LAS float*)(lds + wave * 8448);
    constexpr int I_QKV = (DM / 128) * (NQKV / 32), I_SQ = (DM / 64) * (DM / 32), I_GU = (DM / 64) * (2 * FF / 32), I_DN = (FF / 64) * (DM / 32), I_PP = (PD / 64) * (DM / 32),
                  I_GMI = (DM / 64) * (2 * DM / 32), I_MGU = (DM / 128) * (2 * FE / 32), I_MDN = (FE / 128) * (DM / 32);
    constexpr int NITEMS = I_QKV + I_SQ + I_GU + I_DN + 2 * I_SQ + 2 * I_PP + I_GMI + I_SQ + NE * I_MGU + NE * I_MDN;
    (void)NITEMS;
    if (parts & 2) {
        for (int r = gw; r < I_QKV; r += NGW) { const int nb = NQKV / 32, kb = r / nb, n0 = (r % nb) * 32; transpose_item8(KIN(2), WIN_LD, kb * 128, n0, ws + WS_WQKV, DM, n0, WQKV_SCALE, scr, lane); }
        for (int r = gw; r < I_SQ; r += NGW) { const int nb = DM / 32, kb = r / nb, n0 = (r % nb) * 32; transpose_item(KIN(4), DM, kb * 64, n0, (bf16*)(ws + WS_WO), DM, n0, scr, lane); }
        for (int r = gw; r < I_GU; r += NGW) { const int nb = 2 * FF / 32, kb = r / nb, n0 = (r % nb) * 32; transpose_item(KIN(11), 2 * FF, kb * 64, n0, (bf16*)(ws + WS_WGU), DM, gu_row(n0, FF), scr, lane); }
        for (int r = gw; r < I_DN; r += NGW) { const int nb = DM / 32, kb = r / nb, n0 = (r % nb) * 32; transpose_item(KIN(12), DM, kb * 64, n0, (bf16*)(ws + WS_WDN), FF, n0, scr, lane); }
        for (int r = gw; r < 2 * I_SQ; r += NGW) { const int l = r / I_SQ, q = r % I_SQ, nb = DM / 32, kb = q / nb, n0 = (q % nb) * 32;
            transpose_item(KIN(21) + (size_t)l * DM * DM, DM, kb * 64, n0, (bf16*)(ws + WS_WPG) + (size_t)l * DM * DM, DM, n0, scr, lane); }
        for (int r = gw; r < 2 * I_PP; r += NGW) { const int l = r / I_PP, q = r % I_PP, nb = DM / 32, kb = q / nb, n0 = (q % nb) * 32;
            transpose_item(KIN(20) + (size_t)l * PD * DM, DM, kb * 64, n0, (bf16*)(ws + WS_WPP) + (size_t)l * DM * PD, PD, n0, scr, lane); }
        for (int r = gw; r < I_GMI; r += NGW) { const int nb = 2 * DM / 32, kb = r / nb, n0 = (r % nb) * 32; transpose_item(KIN(5), 2 * DM, kb * 64, n0, (bf16*)(ws + WS_WGMI), DM, n0, scr, lane); }
        for (int r = gw; r < I_SQ; r += NGW) { const int nb = DM / 32, kb = r / nb, n0 = (r % nb) * 32; transpose_item(KIN(10), DM, kb * 64, n0, (bf16*)(ws + WS_WGMO), DM, n0, scr, lane); }
    }
    if (parts & 4) conv_mgu(ws, lds, lane, wave, vcu, G);
    if (parts & 16) conv_mdn(ws, lds, lane, wave, vcu, G);
    const int gt = vcu * (NWAVES * 64) + tid, NGT = G * NWAVES * 64;
    if (parts & 8) {
    { bf16* pb = (bf16*)(ws + WS_PB);
      for (int i = gt; i < 2 * T * PD / 8; i += NGT) { const f32x4 a = *(const f32x4*)(KIN(1) + (size_t)i * 8), b = *(const f32x4*)(KIN(1) + (size_t)i * 8 + 4);
          v4u o; o.x = pk2(a[0], a[1]); o.y = pk2(a[2], a[3]); o.z = pk2(b[0], b[1]); o.w = pk2(b[2], b[3]); *(v4u*)(pb + (size_t)i * 8) = o; } }
    { bf16* wsb = (bf16*)(ws + WS_WSB);
      for (int i = gt; i < GG * GCH * GCH / 8; i += NGT) { const int s0 = (i * 8) & (GCH - 1), t = ((i * 8) >> 7) & (GCH - 1);
          const f32x4 a = *(const f32x4*)(KIN(8) + (size_t)i * 8), b = *(const f32x4*)(KIN(8) + (size_t)i * 8 + 4);
          float v[8] = {a[0], a[1], a[2], a[3], b[0], b[1], b[2], b[3]};
#pragma unroll
          for (int e = 0; e < 8; ++e) v[e] = (s0 + e <= t) ? v[e] : 0.f;
          v4u o; o.x = pk2(v[0], v[1]); o.y = pk2(v[2], v[3]); o.z = pk2(v[4], v[5]); o.w = pk2(v[6], v[7]); *(v4u*)(wsb + (size_t)i * 8) = o; } }
    }
}
__device__ __forceinline__ void cumsum_seq(const float* logf_i, float* kbias, int s, LAS unsigned char* lds, int tid, int lane, int wave) {
    const int b = s >> 4, h = s & 15; double v[8]; double run = 0.0;
#pragma unroll
    for (int e = 0; e < 8; ++e) { run += (double)logf_i[((size_t)b * SEQ + tid * 8 + e) * 16 + h]; v[e] = run; }
    double inc = run;
#pragma unroll
    for (int o = 1; o < 64; o <<= 1) { const double u = __shfl_up(inc, o); if (lane >= o) inc += u; }
    LAS double* wt = (LAS double*)lds;
    if (lane == 63) wt[wave] = inc;
    __syncthreads();
    double base = inc - run;
    for (int w = 0; w < wave; ++w) base += wt[w];
#pragma unroll
    for (int e = 0; e < 8; ++e) kbias[(size_t)s * SEQ + tid * 8 + e] = (float)(-(base + v[e]) * 1.4426950408889634);
    __syncthreads();
}
__device__ __forceinline__ void ln_row(f32x4 (&v)[8], const float* g, const float* b, int lane) {
    float s = 0.f;
#pragma unroll
    for (int j = 0; j < 8; ++j) s += (v[j][0] + v[j][1]) + (v[j][2] + v[j][3]);
    const float mean = wave_sum(s) * (1.f / DM); float s2 = 0.f;
#pragma unroll
    for (int j = 0; j < 8; ++j) { v[j] = v[j] - mean; s2 += (v[j][0] * v[j][0] + v[j][1] * v[j][1]) + (v[j][2] * v[j][2] + v[j][3] * v[j][3]); }
    const float rstd = 1.0f / sqrtf(wave_sum(s2) * (1.f / DM) + LN_EPS);
#pragma unroll
    for (int j = 0; j < 8; ++j) { const f32x4 gv = *(const f32x4*)(g + 256 * j + 4 * lane), bv = *(const f32x4*)(b + 256 * j + 4 * lane); v[j] = v[j] * rstd * gv + bv; }
}
__device__ __forceinline__ void store_row(const f32x4 (&v)[8], float* of, bf16* ob, int lane) {
#pragma unroll
    for (int j = 0; j < 8; ++j) { *(f32x4*)(of + 256 * j + 4 * lane) = v[j]; v2u o; o.x = pk2(v[j][0], v[j][1]); o.y = pk2(v[j][2], v[j][3]); *(v2u*)(ob + 256 * j + 4 * lane) = o; }
}
__device__ __forceinline__ void ln_phase(const float* pre, const float* g, const float* b, float* of, bf16* ob, int lane, int gw, int NGW) {
    for (int m = gw; m < T; m += NGW) { f32x4 v[8];
#pragma unroll
        for (int j = 0; j < 8; ++j) v[j] = *(const f32x4*)(pre + (size_t)m * DM + 256 * j + 4 * lane);
        ln_row(v, g, b, lane); store_row(v, of + (size_t)m * DM, ob + (size_t)m * DM, lane); }
}
__device__ __forceinline__ void ln_router_phase(const float* pre, const float* g, const float* b, float* of, bf16* ob, const float* w_router, unsigned char* route, gu32* ctl,
                                                LAS unsigned char* lds, int tid, int lane, int gw, int NGW) {
    LAS float* wr = (LAS float*)lds;
    for (int i = tid; i < DM * 2; i += NWAVES * 64) { const int k = i >> 1, eq = i & 1; const f32x4 w = *(const f32x4*)(w_router + (size_t)k * NE + eq * 4);
        wr[(eq * 4 + 0) * DM + k] = w[0]; wr[(eq * 4 + 1) * DM + k] = w[1]; wr[(eq * 4 + 2) * DM + k] = w[2]; wr[(eq * 4 + 3) * DM + k] = w[3]; }
    __syncthreads();
    int* tok_e = (int*)(route + RT_E); int* tok_pos = (int*)(route + RT_POS); float* tok_g = (float*)(route + RT_G); int* elist = (int*)(route + RT_LIST);
    for (int m = gw; m < T; m += NGW) { f32x4 v[8];
#pragma unroll
        for (int j = 0; j < 8; ++j) v[j] = *(const f32x4*)(pre + (size_t)m * DM + 256 * j + 4 * lane);
        ln_row(v, g, b, lane); store_row(v, of + (size_t)m * DM, ob + (size_t)m * DM, lane);
        float lg[8];
#pragma unroll
        for (int e = 0; e < 8; ++e) { float a = 0.f;
#pragma unroll
            for (int j = 0; j < 8; ++j) { const f32x4 w = *(const LAS f32x4*)(wr + e * DM + 256 * j + 4 * lane); a += (v[j][0] * w[0] + v[j][1] * w[1]) + (v[j][2] * w[2] + v[j][3] * w[3]); }
            lg[e] = wave_sum(a); }
        int i1 = 0; float v1 = lg[0];
#pragma unroll
        for (int e = 1; e < 8; ++e) if (lg[e] > v1) { v1 = lg[e]; i1 = e; }
        int i2 = -1; float v2 = -__builtin_inff();
#pragma unroll
        for (int e = 0; e < 8; ++e) if (e != i1 && lg[e] > v2) { v2 = lg[e]; i2 = e; }
        const float ex = expf(v2 - v1), g1 = 1.0f / (1.0f + ex), g2 = ex / (1.0f + ex);
        if (lane == 0) { const int p1 = (int)__hip_atomic_fetch_add(ctl + CW_CNT + 64 * i1, 1u, RLX_AGENT), p2 = (int)__hip_atomic_fetch_add(ctl + CW_CNT + 64 * i2, 1u, RLX_AGENT);
            tok_e[2 * m] = i1; tok_e[2 * m + 1] = i2; tok_pos[2 * m] = p1; tok_pos[2 * m + 1] = p2; tok_g[2 * m] = g1; tok_g[2 * m + 1] = g2;
            elist[i1 * T + p1] = m; elist[i2 * T + p2] = m; }
    }
    __syncthreads();
}
__device__ __forceinline__ void moe_tiles(const gu32* ctl, int (&ts)[9], int (&cnt)[8]) {
    ts[0] = 0;
#pragma unroll
    for (int e = 0; e < 8; ++e) { cnt[e] = __builtin_amdgcn_readfirstlane((int)__hip_atomic_load(ctl + CW_CNT + 64 * e, RLX_AGENT)); ts[e + 1] = ts[e] + ((cnt[e] + 255) >> 8); }
}
__device__ __forceinline__ void moe_permute_phase(const float* x4, unsigned char* xs, const unsigned char* route, const gu32* ctl, int lane, int gw, int NGW) {
    int ts[9], cnt[8]; moe_tiles(ctl, ts, cnt);
    const int* elist = (const int*)(route + RT_LIST);
    for (int r = gw; r < ts[8] * 256; r += NGW) { const int mt = r >> 8; int e = 0, t0 = 0, c = cnt[0];
#pragma unroll
        for (int j = 1; j < 8; ++j) if (mt >= ts[j]) { e = j; t0 = ts[j]; c = cnt[j]; }
        const int pos = r - t0 * 256; v2u a[4];
        if (pos < c) { const int tok = elist[e * T + pos];
#pragma unroll
            for (int j = 0; j < 4; ++j) { const f32x4 u0 = *(const f32x4*)(x4 + (size_t)tok * DM + 512 * j + 8 * lane) * XS_SCALE, u1 = *(const f32x4*)(x4 + (size_t)tok * DM + 512 * j + 8 * lane + 4) * XS_SCALE;
                a[j].x = pk4f8(u0[0], u0[1], u0[2], u0[3]); a[j].y = pk4f8(u1[0], u1[1], u1[2], u1[3]); } }
        else {
#pragma unroll
            for (int j = 0; j < 4; ++j) a[j] = (v2u){0u, 0u}; }
#pragma unroll
        for (int j = 0; j < 4; ++j) *(v2u*)(xs + (size_t)r * DM + 512 * j + 8 * lane) = a[j]; }
}
__device__ __forceinline__ void ln_moe_phase(const float* x4, const bf16* ys, const float* g, const float* b, float* of, bf16* ob, const unsigned char* route, const gu32* ctl, int lane, int gw, int NGW) {
    int ts[9], cnt[8]; moe_tiles(ctl, ts, cnt);
    const int* tok_e = (const int*)(route + RT_E); const int* tok_pos = (const int*)(route + RT_POS); const float* tok_g = (const float*)(route + RT_G);
    for (int m = gw; m < T; m += NGW) {
        const int e1 = __builtin_amdgcn_readfirstlane(tok_e[2 * m]), e2 = __builtin_amdgcn_readfirstlane(tok_e[2 * m + 1]);
        const int p1 = __builtin_amdgcn_readfirstlane(tok_pos[2 * m]), p2 = __builtin_amdgcn_readfirstlane(tok_pos[2 * m + 1]);
        const float g1 = tok_g[2 * m], g2 = tok_g[2 * m + 1];
        int t1 = 0, t2 = 0;
#pragma unroll
        for (int j = 0; j < 8; ++j) { t1 = (e1 == j) ? ts[j] : t1; t2 = (e2 == j) ? ts[j] : t2; }
        const bf16* y1 = ys + (size_t)(t1 * 256 + p1) * DM; const bf16* y2 = ys + (size_t)(t2 * 256 + p2) * DM;
        f32x4 v[8];
#pragma unroll
        for (int j = 0; j < 8; ++j) { const f32x4 xv = *(const f32x4*)(x4 + (size_t)m * DM + 256 * j + 4 * lane); const v2u a = *(const v2u*)(y1 + 256 * j + 4 * lane), c = *(const v2u*)(y2 + 256 * j + 4 * lane);
            f32x4 o; o[0] = ALPHA * xv[0] + (g1 * bflo(a.x) + g2 * bflo(c.x)); o[1] = ALPHA * xv[1] + (g1 * bfhi(a.x) + g2 * bfhi(c.x));
            o[2] = ALPHA * xv[2] + (g1 * bflo(a.y) + g2 * bflo(c.y)); o[3] = ALPHA * xv[3] + (g1 * bfhi(a.y) + g2 * bfhi(c.y)); v[j] = o; }
        ln_row(v, g, b, lane); store_row(v, of + (size_t)m * DM, ob + (size_t)m * DM, lane); }
}
__device__ __forceinline__ void gating_unit(int uid, const bf16* uv, const float* vstat, const bf16* wsb, const float* lng, const float* lnb, const float* bs, bf16* yb,
                                            LAS unsigned char* lds, int tid, int lane, int wave) {
    const int bc = uid >> 4, g = uid & 15, tok0 = bc * GCH;
    LAS float* st = (LAS float*)(lds + 32768);
    if (tid < GCH) { const f32x4* sp = (const f32x4*)(vstat + (size_t)(tok0 + tid) * 64); float s = 0.f, q = 0.f;
#pragma unroll
        for (int i = 0; i < 16; ++i) { const f32x4 a = sp[i]; s += a[0] + a[2]; q += a[1] + a[3]; }
        const float mean = s * (1.f / DM), var = fmaxf(q * (1.f / DM) - mean * mean, 0.f);
        st[2 * tid] = mean; st[2 * tid + 1] = 1.0f / sqrtf(var + LN_EPS); }
    __syncthreads();
    { const int sr = tid >> 4, sc = (tid & 15) * 8;
      const f32x4 g0 = *(const f32x4*)(lng + g * GCH + sc), g1 = *(const f32x4*)(lng + g * GCH + sc + 4), b0 = *(const f32x4*)(lnb + g * GCH + sc), b1 = *(const f32x4*)(lnb + g * GCH + sc + 4);
#pragma unroll
      for (int q = 0; q < 4; ++q) { const int s = 32 * q + sr; const v4u raw = *(const v4u*)(uv + (size_t)(tok0 + s) * (2 * DM) + DM + g * GCH + sc);
          const float mean = st[2 * s], rstd = st[2 * s + 1];
          float f[8] = {bflo(raw.x), bfhi(raw.x), bflo(raw.y), bfhi(raw.y), bflo(raw.z), bfhi(raw.z), bflo(raw.w), bfhi(raw.w)};
#pragma unroll
          for (int e = 0; e < 4; ++e) { f[e] = (f[e] - mean) * rstd * g0[e] + b0[e]; f[4 + e] = (f[4 + e] - mean) * rstd * g1[e] + b1[e]; }
          v4u o; o.x = pk2(f[0], f[1]); o.y = pk2(f[2], f[3]); o.z = pk2(f[4], f[5]); o.w = pk2(f[6], f[7]);
          *(LAS v4u*)(lds + (s >> 6) * fox::SHM_V + fox::v_st(s & 63, sc)) = o; } }
    __syncthreads();
    const int r32 = lane & 31, hi = lane >> 5, ib = wave >> 1, dh = wave & 1;
    bf16x8 pa[8];
#pragma unroll
    for (int ks = 0; ks < 8; ++ks) pa[ks] = *(const bf16x8*)(wsb + ((size_t)(g * GCH + 32 * ib + r32)) * GCH + 16 * ks + 8 * hi);
    const int vb0 = (int)(uintptr_t)lds + fox::v_rd_base(lane) + dh * 1024;
    f32x16 o[2] = {};
#define G_TRRD(dst, off) asm volatile("ds_read_b64_tr_b16 %0, %1 offset:%2" : "=&v"(dst) : "v"(vb0), "i"(off) : "memory")
#define G_D0(ti, dd) do { s16x4 l0, l1, l2, l3, h0, h1, h2, h3; \
        G_TRRD(l0, (ti) * 16384 + (dd) * 512); G_TRRD(h0, (ti) * 16384 + (dd) * 512 + 2048); G_TRRD(l1, (ti) * 16384 + (dd) * 512 + 4096); G_TRRD(h1, (ti) * 16384 + (dd) * 512 + 6144); \
        G_TRRD(l2, (ti) * 16384 + (dd) * 512 + 8192); G_TRRD(h2, (ti) * 16384 + (dd) * 512 + 10240); G_TRRD(l3, (ti) * 16384 + (dd) * 512 + 12288); G_TRRD(h3, (ti) * 16384 + (dd) * 512 + 14336); \
        asm volatile("s_waitcnt lgkmcnt(0)" ::: "memory"); __builtin_amdgcn_sched_barrier(0); \
        o[dd] = __builtin_amdgcn_mfma_f32_32x32x16_bf16(pa[4 * (ti) + 0], (bf16x8){l0[0], l0[1], l0[2], l0[3], h0[0], h0[1], h0[2], h0[3]}, o[dd], 0, 0, 0); \
        o[dd] = __builtin_amdgcn_mfma_f32_32x32x16_bf16(pa[4 * (ti) + 1], (bf16x8){l1[0], l1[1], l1[2], l1[3], h1[0], h1[1], h1[2], h1[3]}, o[dd], 0, 0, 0); \
        o[dd] = __builtin_amdgcn_mfma_f32_32x32x16_bf16(pa[4 * (ti) + 2], (bf16x8){l2[0], l2[1], l2[2], l2[3], h2[0], h2[1], h2[2], h2[3]}, o[dd], 0, 0, 0); \
        o[dd] = __builtin_amdgcn_mfma_f32_32x32x16_bf16(pa[4 * (ti) + 3], (bf16x8){l3[0], l3[1], l3[2], l3[3], h3[0], h3[1], h3[2], h3[3]}, o[dd], 0, 0, 0); } while (0)
    G_D0(0, 0); G_D0(0, 1); G_D0(1, 0); G_D0(1, 1);
#undef G_D0
#undef G_TRRD
#pragma unroll
    for (int r = 0; r < 16; ++r) { const int t = 32 * ib + fox::crow(r, hi); const float bsv = bs[g * GCH + t];
#pragma unroll
        for (int dd = 0; dd < 2; ++dd) { const int col = g * GCH + (2 * dh + dd) * 32 + r32;
            const float uval = __uint_as_float((unsigned)uv[(size_t)(tok0 + t) * (2 * DM) + col] << 16);
            const float v = uval * (o[dd][r] + bsv), vn = __shfl_xor(v, 1);
            if ((r32 & 1) == 0) *(unsigned*)(yb + (size_t)(tok0 + t) * DM + col) = pk2(v, vn); } }
    __syncthreads();
}
struct Args { const void* in[22]; float* out; unsigned char* ws; int ph_lo, ph_hi, p0_mask, pad; };
__global__ void __launch_bounds__(NWAVES * 64, 2) fwd(Args args) {
    extern __shared__ __attribute__((aligned(16))) unsigned char lds_raw[];
    LAS unsigned char* lds = (LAS unsigned char*)lds_raw;
    volatile LAS unsigned* MISC = (volatile LAS unsigned*)(lds + MISC_OFF);
    const int tid0 = threadIdx.x;
    const int G = gridDim.x, bx = blockIdx.x, vcu = (G % 8 == 0) ? (bx % 8) * (G / 8) + bx / 8 : bx;
    const int NGW = G * NWAVES;
    unsigned char* ws = (unsigned char*)karg_ptr(23); gu32* ctl = (gu32*)(ws + WS_CTL);
#define x_in ((const float*)karg_ptr(0))
#define p_in ((const float*)karg_ptr(1))
#define fox_w_in ((const float*)karg_ptr(2))
#define fox_b_f ((const float*)karg_ptr(3))
#define fox_w_o ((const float*)karg_ptr(4))
#define gm_w_in ((const float*)karg_ptr(5))
#define gm_ln_v_g ((const float*)karg_ptr(6))
#define gm_ln_v_b ((const float*)karg_ptr(7))
#define gm_w_s ((const float*)karg_ptr(8))
#define gm_b_s ((const float*)karg_ptr(9))
#define gm_w_o ((const float*)karg_ptr(10))
#define ffn_w_gu ((const float*)karg_ptr(11))
#define ffn_w_down ((const float*)karg_ptr(12))
#define moe_w_router ((const float*)karg_ptr(13))
#define moe_w_gu ((const float*)karg_ptr(14))
#define moe_w_down ((const float*)karg_ptr(15))
#define ln_mix_g ((const float*)karg_ptr(16))
#define ln_mix_b ((const float*)karg_ptr(17))
#define ln_ch_g ((const float*)karg_ptr(18))
#define ln_ch_b ((const float*)karg_ptr(19))
#define ple_w_proj ((const float*)karg_ptr(20))
#define ple_w_gate ((const float*)karg_ptr(21))
#define Wqkv ((bf16*)(ws + WS_WQKV))
#define Wo ((bf16*)(ws + WS_WO))
#define Wgu ((bf16*)(ws + WS_WGU))
#define Wdn ((bf16*)(ws + WS_WDN))
#define Wpg ((bf16*)(ws + WS_WPG))
#define Wpp ((bf16*)(ws + WS_WPP))
#define Wgmi ((bf16*)(ws + WS_WGMI))
#define Wsb ((bf16*)(ws + WS_WSB))
#define Wgmo ((bf16*)(ws + WS_WGMO))
#define Wmgu ((bf16*)(ws + WS_WMGU))
#define Wmdn ((bf16*)(ws + WS_WMDN))
#define X0B ((bf16*)(ws + WS_X0B))
#define QKV ((bf16*)(ws + WS_QKV))
#define OB ((bf16*)(ws + WS_O))
#define X1B ((bf16*)(ws + WS_X1B))
#define HB ((bf16*)(ws + WS_HB))
#define X2B ((bf16*)(ws + WS_X2B))
#define PW ((bf16*)(ws + WS_PW))
#define X3B ((bf16*)(ws + WS_X3B))
#define UV ((bf16*)(ws + WS_UV))
#define YB ((bf16*)(ws + WS_YB))
#define X4B ((bf16*)(ws + WS_X4B))
#define XS ((bf16*)(ws + WS_XS))
#define HM ((bf16*)(ws + WS_HM))
#define YS ((bf16*)(ws + WS_YS))
#define X5B ((bf16*)(ws + WS_X5B))
#define PB ((bf16*)(ws + WS_PB))
#define PRE ((float*)(ws + WS_PRE))
#define X1F ((float*)(ws + WS_X1F))
#define X2F ((float*)(ws + WS_X2F))
#define X3F ((float*)(ws + WS_X3F))
#define X4F ((float*)(ws + WS_X4F))
#define X5F ((float*)(ws + WS_X5F))
#define VSTAT ((float*)(ws + WS_VSTAT))
#define LOGF ((float*)(ws + WS_LOGF))
#define KBIAS ((float*)(ws + WS_KBIAS))
#define ROUTE (ws + WS_ROUTE)

    for (int u = tid0; u < (LDS_BYTES - LDSCTL_OFF) / 4; u += NWAVES * 64) ((LAS unsigned*)(lds + LDSCTL_OFF))[u] = 0u;
    __syncthreads();
    constexpr bool ONE = (MK_N_LAUNCHES == 1);
    XcdBarrier bar; bar.bar = (unsigned*)(ctl + CW_BAR); bar.x = 0; bar.st = nullptr;
    if (ONE) bar = xcd_barrier_post((unsigned*)(ctl + CW_BAR), MISC + 8);
    const int lo = args.ph_lo, hi = args.ph_hi;
    const int NJ = G >> 3; const bool OVERLAP_OK = (G % 8 == 0) && G >= 64 && lo == 0 && hi == N_PHASES;
#ifndef PH_MASK
#define PH_MASK 0x3ffff
#endif
#define IN(k) (((PH_MASK >> (k)) & 1) && lo <= (k) && (k) < hi)
#define PHASE(k) if (IN(k))
#define LANE_IDS const int tid = opaque_tid(), lane = tid & 63, wave = __builtin_amdgcn_readfirstlane(tid >> 6), gw = vcu * NWAVES + wave; (void)tid; (void)lane; (void)wave; (void)gw
#define SEAM(k) do { if (ONE && IN((k) + 1)) xcd_barrier(bar); } while (0)
#define GEMM_CALL(EPI, ORD, g, S, E) pg8::gemm_phase<EPI, ORD, true, true>((PG8_LAS unsigned char*)lds, g, S, E)

    PHASE(0) { LANE_IDS;
        p0_prologue(ws, lds, tid, lane, wave, vcu, G, OVERLAP_OK ? (args.p0_mask & ~(CONV_IN_P5 ? 4 : 0) & ~(CONV_IN_P14 ? 16 : 0)) : args.p0_mask);
        SEAM(0);
    }
    PHASE(1) { LANE_IDS;
        for (int s = vcu; s < NB * NH; s += G) cumsum_seq(LOGF, KBIAS, s, lds, tid, lane, wave);
        __syncthreads();
        { pg8::Gemm g{X0B, Wqkv, T, NQKV, DM / 2}; pg8::StaticOrder S; S.init(T, NQKV, G, bx); pg8::EpiBf16S E{QKV, DM, DM, (size_t)T * DM, 1.f / (XS_SCALE * WQKV_SCALE)};
          pg8::gemm_phase<pg8::EpiBf16S, pg8::StaticOrder, true, true, true>((PG8_LAS unsigned char*)lds, g, S, E); }
        { pg8::Gemm g{PB, Wpp, T, DM, PD}; pg8::StaticOrder S; S.init(T, DM, G, bx); pg8::EpiBf16S E{PW, DM, 0, 0, 1.f}; GEMM_CALL(pg8::EpiBf16S, pg8::StaticOrder, g, S, E); }
        { pg8::Gemm g{PB + (size_t)T * PD, Wpp + (size_t)DM * PD, T, DM, PD}; pg8::StaticOrder S; S.init(T, DM, G, bx); pg8::EpiBf16S E{PW + (size_t)T * DM, DM, 0, 0, 1.f}; GEMM_CALL(pg8::EpiBf16S, pg8::StaticOrder, g, S, E); }
        SEAM(1);
    }
    PHASE(2) { LANE_IDS;
        static_assert(fox::LDS_BYTES <= RING_BYTES, "attention LDS");
        fox::fox_phase((char*)lds_raw, (const fox::bf16*)QKV, (fox::bf16*)OB, KBIAS, vcu, G);
        SEAM(2);
    }
    PHASE(3) { LANE_IDS;
        pg8::Gemm g{OB, Wo, T, DM, DM}; pg8::StaticOrder S; S.init(T, DM, G, bx); pg8::EpiResF32 E{x_in, PRE, DM, ALPHA}; GEMM_CALL(pg8::EpiResF32, pg8::StaticOrder, g, S, E);
        SEAM(3);
    }
    PHASE(4) { LANE_IDS; ln_phase(PRE, ln_mix_g, ln_mix_b, X1F, X1B, lane, gw, NGW); SEAM(4); }
    PHASE(5) { LANE_IDS;
        const int jx = bx >> 3, x8 = bx & 7, JG5 = (OVERLAP_OK && CONV_IN_P5) ? (NJ * P5_GEMM_16THS) / 16 : NJ;
        if (jx < JG5 || !OVERLAP_OK) { pg8::Gemm g{X1B, Wgu, T, 2 * FF, DM}; pg8::StaticOrder S; S.init(T, 2 * FF, OVERLAP_OK ? JG5 * 8 : G, OVERLAP_OK ? jx * 8 + x8 : bx); pg8::EpiSwiGLU E{HB, FF}; GEMM_CALL(pg8::EpiSwiGLU, pg8::StaticOrder, g, S, E); }
        else conv_mgu(ws, lds, lane, wave, (jx - JG5) * 8 + x8, (NJ - JG5) * 8);
        SEAM(5);
    }
    PHASE(6) { LANE_IDS;
        pg8::Gemm g{HB, Wdn, T, DM, FF}; pg8::StaticOrder S; S.init(T, DM, G, bx); pg8::EpiResF32 E{X1F, PRE, DM, ALPHA}; GEMM_CALL(pg8::EpiResF32, pg8::StaticOrder, g, S, E);
        SEAM(6);
    }
    PHASE(7) { LANE_IDS; ln_phase(PRE, ln_ch_g, ln_ch_b, X2F, X2B, lane, gw, NGW); SEAM(7); }
    PHASE(8) { LANE_IDS;
        pg8::Gemm g{X2B, Wpg, T, DM, DM}; pg8::StaticOrder S; S.init(T, DM, G, bx); pg8::EpiPLE E{X2F, PW, X3F, X3B, DM}; GEMM_CALL(pg8::EpiPLE, pg8::StaticOrder, g, S, E);
        SEAM(8);
    }
    PHASE(9) { LANE_IDS;
        pg8::Gemm g{X3B, Wgmi, T, 2 * DM, DM}; pg8::StaticOrder S; S.init(T, 2 * DM, G, bx); pg8::EpiGeluStats E{UV, 2 * DM, VSTAT, DM / 256}; GEMM_CALL(pg8::EpiGeluStats, pg8::StaticOrder, g, S, E);
        SEAM(9);
    }
    PHASE(10) { LANE_IDS;
        for (int uid = vcu; uid < (T / GCH) * GG; uid += G) gating_unit(uid, UV, VSTAT, Wsb, gm_ln_v_g, gm_ln_v_b, gm_b_s, YB, lds, tid, lane, wave);
        SEAM(10);
    }
    PHASE(11) { LANE_IDS;
        pg8::Gemm g{YB, Wgmo, T, DM, DM}; pg8::StaticOrder S; S.init(T, DM, G, bx); pg8::EpiResF32 E{X3F, PRE, DM, ALPHA}; GEMM_CALL(pg8::EpiResF32, pg8::StaticOrder, g, S, E);
        SEAM(11);
    }
    PHASE(12) { LANE_IDS; ln_router_phase(PRE, ln_mix_g + DM, ln_mix_b + DM, X4F, X4B, moe_w_router, ROUTE, ctl, lds, tid, lane, gw, NGW); SEAM(12); }
    PHASE(13) { LANE_IDS; moe_permute_phase(X4F, (unsigned char*)XS, ROUTE, ctl, lane, gw, NGW); SEAM(13); }
    PHASE(14) { LANE_IDS;
        int ts[9], cnt[8]; moe_tiles(ctl, ts, cnt);
        const int jx = bx >> 3, x8 = bx & 7, JG14 = (OVERLAP_OK && CONV_IN_P14) ? (NJ * P14_GEMM_16THS) / 16 : NJ;
        if (jx < JG14 || !OVERLAP_OK) { pg8::Gemm g{XS, Wmgu, MOE_ROWS, 2 * FE, DM / 2}; pg8::MoeOrder S; S.init(ts, 2 * FE / 256, OVERLAP_OK ? JG14 * 8 : G, OVERLAP_OK ? jx * 8 + x8 : bx);
            pg8::EpiSwiGLU8 E{(unsigned char*)HM, FE, 1.f / (XS_SCALE * WGU_SCALE), H_SCALE};
            pg8::gemm_phase<pg8::EpiSwiGLU8, pg8::MoeOrder, true, true, true>((PG8_LAS unsigned char*)lds, g, S, E); }
        else conv_mdn(ws, lds, lane, wave, (jx - JG14) * 8 + x8, (NJ - JG14) * 8);
        SEAM(14);
    }
    PHASE(15) { LANE_IDS;
        int ts[9], cnt[8]; moe_tiles(ctl, ts, cnt);
        pg8::Gemm g{HM, Wmdn, MOE_ROWS, DM, FE / 2}; pg8::MoeOrder S; S.init(ts, DM / 256, G, bx); pg8::EpiBf16S E{YS, DM, 0, 0, 1.f / (H_SCALE * WDN_SCALE)};
        pg8::gemm_phase<pg8::EpiBf16S, pg8::MoeOrder, true, true, true>((PG8_LAS unsigned char*)lds, g, S, E);
        SEAM(15);
    }
    PHASE(16) { LANE_IDS; ln_moe_phase(X4F, YS, ln_ch_g + DM, ln_ch_b + DM, X5F, X5B, ROUTE, ctl, lane, gw, NGW); SEAM(16); }
    PHASE(17) { LANE_IDS;
        pg8::Gemm g{X5B, Wpg + (size_t)DM * DM, T, DM, DM}; pg8::StaticOrder S; S.init(T, DM, G, bx); pg8::EpiPLE E{X5F, PW + (size_t)T * DM, (float*)karg_ptr(22), nullptr, DM}; GEMM_CALL(pg8::EpiPLE, pg8::StaticOrder, g, S, E);
    }
#undef IN
#undef SEAM
#undef PHASE
#undef LANE_IDS
#undef GEMM_CALL
#undef x_in
#undef p_in
#undef fox_w_in
#undef fox_b_f
#undef fox_w_o
#undef gm_w_in
#undef gm_ln_v_g
#undef gm_ln_v_b
#undef gm_w_s
#undef gm_b_s
#undef gm_w_o
#undef ffn_w_gu
#undef ffn_w_down
#undef moe_w_router
#undef moe_w_gu
#undef moe_w_down
#undef ln_mix_g
#undef ln_mix_b
#undef ln_ch_g
#undef ln_ch_b
#undef ple_w_proj
#undef ple_w_gate
#undef Wqkv
#undef Wo
#undef Wgu
#undef Wdn
#undef Wpg
#undef Wpp
#undef Wgmi
#undef Wsb
#undef Wgmo
#undef Wmgu
#undef Wmdn
#undef X0B
#undef QKV
#undef OB
#undef X1B
#undef HB
#undef X2B
#undef PW
#undef X3B
#undef UV
#undef YB
#undef X4B
#undef XS
#undef HM
#undef YS
#undef X5B
#undef PB
#undef PRE
#undef X1F
#undef X2F
#undef X3F
#undef X4F
#undef X5F
#undef VSTAT
#undef LOGF
#undef KBIAS
#undef ROUTE
}

extern "C" void kernel_launch(void* const* d_in, const int* in_sizes, int n_in, void* d_out, int out_size, void* d_ws, size_t ws_size, hipStream_t stream) {
    static int grid = 0;
    if (grid == 0) {
        if (n_in != 22 || in_sizes[0] != T * DM || out_size != T * DM || ws_size < WS_END) {
            fprintf(stderr, "kernel_launch: built for 22 inputs, x/out of %d floats, >= %zu bytes of workspace; got n_in %d, in0 %d, out %d, ws %zu; nothing launched\n", T * DM, (size_t)WS_END, n_in, n_in > 0 ? in_sizes[0] : -1, out_size, ws_size);
            grid = -1; return; }
        int dev = 0, cus = 0, per_cu = 0;
        if (hipGetDevice(&dev) != hipSuccess || hipDeviceGetAttribute(&cus, hipDeviceAttributeMultiprocessorCount, dev) != hipSuccess) { fprintf(stderr, "kernel_launch: device query failed\n"); grid = -1; return; }
        if (hipFuncSetAttribute((const void*)fwd, hipFuncAttributeMaxDynamicSharedMemorySize, LDS_BYTES) != hipSuccess) { fprintf(stderr, "kernel_launch: hipFuncSetAttribute failed\n"); grid = -1; return; }
        if (hipOccupancyMaxActiveBlocksPerMultiprocessor(&per_cu, (const void*)fwd, NWAVES * 64, LDS_BYTES) != hipSuccess || per_cu < 1)
            fprintf(stderr, "kernel_launch: note: occupancy query reports %d workgroups per CU\n", per_cu);
        (void)hipGetLastError();
        grid = cus;
    }
    if (grid < 0) return;
    if (hipMemsetAsync((char*)d_ws + WS_CTL, 0, CTL_ZERO_BYTES, stream) != hipSuccess) { fprintf(stderr, "kernel_launch: memset failed\n"); return; }
    Args a{};
    for (int i = 0; i < 22; ++i) a.in[i] = d_in[i];
    a.out = (float*)d_out; a.ws = (unsigned char*)d_ws; a.p0_mask = 0x1F; a.pad = 0;
    for (int li = 0; li < MK_N_LAUNCHES; ++li) {
        a.ph_lo = (MK_N_LAUNCHES == 1) ? 0 : li; a.ph_hi = (MK_N_LAUNCHES == 1) ? N_PHASES : li + 1;
        hipLaunchKernelGGL(fwd, dim3(grid), dim3(NWAVES * 64), LDS_BYTES, stream, a);
        const hipError_t le = hipPeekAtLastError();
        if (le != hipSuccess) { fprintf(stderr, "kernel_launch: launch %d failed: %s\n", li, hipGetErrorName(le)); break; }
    }
#ifndef PROBE_P0
#define PROBE_P0 0x1F
#endif
#ifndef PROBE_GRID_DIV
#define PROBE_GRID_DIV 1
#endif
#ifdef PROBE_MASK
    for (int k = 0; k < N_PHASES; ++k) if ((PROBE_MASK >> k) & 1) { a.ph_lo = k; a.ph_hi = k + 1; a.p0_mask = PROBE_P0; hipLaunchKernelGGL(fwd, dim3(grid / PROBE_GRID_DIV), dim3(NWAVES * 64), LDS_BYTES, stream, a); }
#endif
}
```
